# Optimizing an MI355X kernel written in HIP

```python
import math
import jax
import jax.numpy as jnp
from jax import lax
import numpy as np

D_MODEL = 1024
BATCH = 8
SEQ = 2048
DEPTH = 1

HEAD_DIM = 64
MOBA_HEADS = 6
RWKV_HEADS = 6
MEM_HEADS = 4
MOBA_W = MOBA_HEADS * HEAD_DIM
RWKV_W = RWKV_HEADS * HEAD_DIM
MEM_W = MEM_HEADS * HEAD_DIM
MIX_W = MOBA_W + RWKV_W + MEM_W
MOBA_BLOCK = 256
MOBA_TOPK = 3
MOBA_QCHUNK = 64
N_BUCKETS = 32
MAX_DISTANCE = 128
DECAY_LORA = 64
AAA_LORA = 64
GATE_LORA = 128
RWKV_COLS = 3 * RWKV_W + DECAY_LORA + AAA_LORA + GATE_LORA
RWKV_GN_EPS = 64e-5
N_MEM = 256
IN_COLS = 3 * MOBA_W + RWKV_COLS + MEM_W
N_EXPERTS = 32
TOP_K = 4
D_EXPERT = D_MODEL
SWIGLU_ALPHA = 1.702
SWIGLU_LIMIT = 7.0
MOE_BLOCK = 128
RMS_EPS = 1e-5

kernel_name = 'hymba_moba_rwkv7_memxattn_moe'


def rmsnorm(x, g):
    xf = x.astype(jnp.float32)
    y = xf * lax.rsqrt(jnp.mean(xf * xf, axis=-1, keepdims=True) + RMS_EPS)
    return (y * g.astype(jnp.float32)).astype(x.dtype)


def t5_bucket(dist):
    n = jnp.maximum(dist, 0)
    max_exact = N_BUCKETS // 2
    nf = jnp.maximum(n, 1).astype(jnp.float32)
    large = max_exact + (jnp.log(nf / max_exact) / math.log(MAX_DISTANCE / max_exact)
                         * (N_BUCKETS - max_exact)).astype(jnp.int32)
    large = jnp.minimum(large, N_BUCKETS - 1)
    return jnp.where(n < max_exact, n, large)


def moba_attention(q, k, v, rel_bias):
    B, S, H, dh = q.shape
    nb = -(-S // MOBA_BLOCK)
    topk = min(MOBA_TOPK, nb)
    nc = S // MOBA_QCHUNK
    scale = dh ** -0.5

    def blocks(t):
        t = jnp.pad(t, ((0, 0), (0, nb * MOBA_BLOCK - S), (0, 0), (0, 0)))
        return t.transpose(0, 2, 1, 3).reshape(B, H, nb, MOBA_BLOCK, dh)

    kb, vb = blocks(k), blocks(v)
    qh = q.transpose(0, 2, 1, 3)
    k_mean = jnp.mean(kb, axis=3)
    q_blk = jnp.arange(S) // MOBA_BLOCK
    past = jnp.arange(nb)[None, :] < q_blk[:, None]
    gate = jnp.einsum('bhsd,bhnd->bhsn', qh, k_mean).astype(jnp.float32)
    gate = jnp.where(past, gate, -jnp.inf)
    _, sel = lax.top_k(gate, topk)
    valid = sel < q_blk[:, None]
    bias_h = rel_bias.astype(jnp.float32).T
    b_idx = jnp.arange(B)[:, None, None, None]
    h_idx = jnp.arange(H)[None, :, None, None]
    offs = jnp.arange(MOBA_BLOCK)

    def chunks(t):
        t = t.reshape(t.shape[:2] + (nc, MOBA_QCHUNK) + t.shape[3:])
        return jnp.moveaxis(t, 2, 0)

    def attend_chunk(args):
        qc, selc, validc, ci = args
        q_pos = ci * MOBA_QCHUNK + jnp.arange(MOBA_QCHUNK)
        own = (ci * MOBA_QCHUNK) // MOBA_BLOCK
        kg = kb[b_idx, h_idx, selc]
        vg = vb[b_idx, h_idx, selc]
        kpos_g = selc[..., None] * MOBA_BLOCK + offs
        bias_g = bias_h[h_idx[..., None], t5_bucket(q_pos[:, None, None] - kpos_g)]
        s_g = jnp.einsum('bhqd,bhqkjd->bhqkj', qc, kg).astype(jnp.float32) * scale + bias_g
        s_g = jnp.where(validc[..., None], s_g, -jnp.inf)
        k_own = lax.dynamic_index_in_dim(kb, own, axis=2, keepdims=False)
        v_own = lax.dynamic_index_in_dim(vb, own, axis=2, keepdims=False)
        kpos_own = own * MOBA_BLOCK + offs
        bias_own = bias_h[:, t5_bucket(q_pos[:, None] - kpos_own[None, :])]
        s_own = jnp.einsum('bhqd,bhjd->bhqj', qc, k_own).astype(jnp.float32) * scale + bias_own
        s_own = jnp.where(kpos_own[None, :] <= q_pos[:, None], s_own, -jnp.inf)
        logits = jnp.concatenate([s_g.reshape(B, H, MOBA_QCHUNK, topk * MOBA_BLOCK), s_own], axis=-1)
        p = jax.nn.softmax(logits, axis=-1).astype(vb.dtype)
        p_g = p[..., :topk * MOBA_BLOCK].reshape(B, H, MOBA_QCHUNK, topk, MOBA_BLOCK)
        p_own = p[..., topk * MOBA_BLOCK:]
        return (jnp.einsum('bhqkj,bhqkjd->bhqd', p_g, vg)
                + jnp.einsum('bhqj,bhjd->bhqd', p_own, v_own))

    out = lax.map(attend_chunk, (chunks(qh), chunks(sel), chunks(valid), jnp.arange(nc)))
    out = jnp.moveaxis(out, 0, 2).reshape(B, H, S, dh)
    return out.transpose(0, 2, 1, 3).reshape(B, S, H * dh)


def token_shift(p):
    return jnp.pad(p, ((0, 0), (1, 0), (0, 0)))[:, :-1]


def rwkv7_time_mix(p, mu, w0, w_up, a0, a_up, g_up, k_k, k_a, r_k, gn_g, gn_b):
    B, S, _ = p.shape
    H, N = RWKV_HEADS, HEAD_DIM
    f32 = jnp.float32
    p = p + (token_shift(p) - p) * mu
    r, k, v, xw, xa, xg = jnp.split(
        p, [RWKV_W, 2 * RWKV_W, 3 * RWKV_W, 3 * RWKV_W + DECAY_LORA,
            3 * RWKV_W + DECAY_LORA + AAA_LORA], axis=-1)
    w = -jax.nn.softplus(-(w0 + jnp.tanh(xw) @ w_up)) - 0.5
    decay = jnp.exp(-jnp.exp(w.astype(f32)))
    a = jax.nn.sigmoid(a0 + xa @ a_up)
    g = jax.nn.sigmoid(xg) @ g_up
    heads = lambda t: t.astype(f32).reshape(B, S, H, N)
    kk = heads(k * k_k)
    kk = kk / jnp.maximum(jnp.sqrt(jnp.sum(kk * kk, axis=-1, keepdims=True)), 1e-12)
    k = k * (1.0 + (a - 1.0) * k_a)
    r, k, v, decay, a = heads(r), heads(k), heads(v), heads(decay), heads(a)

    def step(state, inp):
        r_t, w_t, k_t, v_t, a_t, b_t = inp
        sa = jnp.einsum('bhij,bhj->bhi', state, a_t)
        state = (state * w_t[:, :, None, :] + sa[..., None] * b_t[:, :, None, :]
                 + v_t[..., None] * k_t[:, :, None, :])
        return state, jnp.einsum('bhij,bhj->bhi', state, r_t)

    seq_first = lambda t: jnp.moveaxis(t, 1, 0)
    xs = tuple(seq_first(t) for t in (r, decay, k, v, -kk, kk * a))
    _, o = lax.scan(step, jnp.zeros((B, H, N, N), f32), xs)
    o = seq_first(o)
    mean = jnp.mean(o, axis=-1, keepdims=True)
    var = jnp.mean(jnp.square(o - mean), axis=-1, keepdims=True)
    o = (o - mean) * lax.rsqrt(var + RWKV_GN_EPS)
    o = o.reshape(B, S, H * N) * gn_g.astype(f32) + gn_b.astype(f32)
    o = o + (jnp.sum(r * k * r_k.astype(f32), axis=-1, keepdims=True) * v).reshape(B, S, H * N)
    return (o * g.astype(f32)).astype(p.dtype)


def memory_attention(q, mk, mv):
    scale = q.shape[-1] ** -0.5
    s = jnp.einsum('bshd,bmhd->bhsm', q, mk).astype(jnp.float32) * scale
    p = jax.nn.softmax(s, axis=-1).astype(mv.dtype)
    o = jnp.einsum('bhsm,bmhd->bshd', p, mv)
    return o.reshape(q.shape[0], q.shape[1], -1)


def moe_ffn(h, w_router, b_router, w_gate_up, b_gate_up, w_down, b_down):
    B, S, D = h.shape
    T = B * S
    A = T * TOP_K
    xt = h.reshape(T, D)
    logits = (xt @ w_router + b_router).astype(jnp.float32)
    top_val, top_idx = lax.top_k(logits, TOP_K)
    top_w = jax.nn.softmax(top_val, axis=-1)
    e_flat = top_idx.reshape(A).astype(jnp.int32)
    tok_flat = jnp.arange(A, dtype=jnp.int32) // TOP_K
    w_flat = top_w.reshape(A)
    e_sorted, order = lax.sort((e_flat, jnp.arange(A, dtype=jnp.int32)), num_keys=1, is_stable=True)
    counts = jnp.bincount(e_flat, length=N_EXPERTS)
    starts = jnp.cumsum(counts) - counts
    padded = (counts + MOE_BLOCK - 1) // MOE_BLOCK * MOE_BLOCK
    pad_ends = jnp.cumsum(padded)
    pad_starts = pad_ends - padded
    dest = pad_starts[e_sorted] + (jnp.arange(A, dtype=jnp.int32) - starts[e_sorted])
    n_blocks = -(-A // MOE_BLOCK) + N_EXPERTS
    P = n_blocks * MOE_BLOCK
    row_tok = jnp.zeros((P,), jnp.int32).at[dest].set(tok_flat[order])
    row_w = jnp.zeros((P,), jnp.float32).at[dest].set(w_flat[order])
    blk_start = jnp.arange(n_blocks, dtype=jnp.int32) * MOE_BLOCK
    blk_expert = jnp.minimum(jnp.searchsorted(pad_ends, blk_start, side='right'), N_EXPERTS - 1)
    xs = xt[row_tok].reshape(n_blocks, MOE_BLOCK, D)

    def expert_block(args):
        xb, e = args
        gu = xb @ w_gate_up[e] + b_gate_up[e]
        gate, up = gu[:, ::2], gu[:, 1::2]
        gate = jnp.minimum(gate, SWIGLU_LIMIT)
        up = jnp.clip(up, -SWIGLU_LIMIT, SWIGLU_LIMIT)
        glu = gate * jax.nn.sigmoid(gate * SWIGLU_ALPHA)
        return ((up + 1.0) * glu) @ w_down[e] + b_down[e]

    ys = lax.map(expert_block, (xs, blk_expert)).reshape(P, D)
    out = jax.ops.segment_sum(ys * row_w[:, None].astype(ys.dtype), row_tok, num_segments=T)
    return out.reshape(B, S, D)


def setup_inputs(seed: int = 0) -> dict:
    key = jax.random.key(seed)
    ks = jax.random.split(key, 32)
    f32 = jnp.float32
    L = DEPTH

    def nrm(k, shape, s):
        return jax.random.normal(k, shape, f32) * s

    return {
        'x': nrm(ks[0], (BATCH, SEQ, D_MODEL), 1.0),
        'mem': nrm(ks[1], (BATCH, N_MEM, D_MODEL), 1.0),
        'w_in': nrm(ks[2], (L, D_MODEL, IN_COLS), D_MODEL ** -0.5),
        'w_out': nrm(ks[3], (L, MIX_W, D_MODEL), MIX_W ** -0.5),
        'w_mem_kv': nrm(ks[4], (L, D_MODEL, 2 * MEM_W), D_MODEL ** -0.5),
        'g_mix': 1.0 + nrm(ks[5], (L, D_MODEL), 0.02),
        'g_mem': 1.0 + nrm(ks[6], (L, D_MODEL), 0.02),
        'g_ffn': 1.0 + nrm(ks[7], (L, D_MODEL), 0.02),
        'g_final': 1.0 + nrm(ks[8], (D_MODEL,), 0.02),
        'rel_bias': nrm(ks[9], (N_BUCKETS, MOBA_HEADS), 0.3),
        'rwkv_mu': jax.random.uniform(ks[10], (L, RWKV_COLS), f32),
        'rwkv_w0': jax.random.uniform(ks[11], (L, RWKV_W), f32, -6.0, 0.0),
        'rwkv_w_up': nrm(ks[12], (L, DECAY_LORA, RWKV_W), 0.1 * DECAY_LORA ** -0.5),
        'rwkv_a0': nrm(ks[13], (L, RWKV_W), 0.1),
        'rwkv_a_up': nrm(ks[14], (L, AAA_LORA, RWKV_W), 0.5 * AAA_LORA ** -0.5),
        'rwkv_g_up': nrm(ks[15], (L, GATE_LORA, RWKV_W), GATE_LORA ** -0.5),
        'rwkv_k_k': 0.85 + nrm(ks[16], (L, RWKV_W), 0.02),
        'rwkv_k_a': 1.0 + nrm(ks[17], (L, RWKV_W), 0.02),
        'rwkv_r_k': nrm(ks[18], (L, RWKV_HEADS, HEAD_DIM), 0.1),
        'rwkv_gn_g': 1.0 + nrm(ks[19], (L, RWKV_W), 0.02),
        'rwkv_gn_b': nrm(ks[20], (L, RWKV_W), 0.02),
        'w_router': nrm(ks[21], (L, D_MODEL, N_EXPERTS), D_MODEL ** -0.5),
        'b_router': nrm(ks[22], (L, N_EXPERTS), 0.01),
        'w_gate_up': nrm(ks[23], (L, N_EXPERTS, D_MODEL, 2 * D_EXPERT), D_MODEL ** -0.5),
        'b_gate_up': nrm(ks[24], (L, N_EXPERTS, 2 * D_EXPERT), 0.01),
        'w_down': nrm(ks[25], (L, N_EXPERTS, D_EXPERT, D_MODEL), D_EXPERT ** -0.5),
        'b_down': nrm(ks[26], (L, N_EXPERTS, D_MODEL), 0.01),
    }


def reference(x, mem, w_in, w_out, w_mem_kv, g_mix, g_mem, g_ffn, g_final, rel_bias,
              rwkv_mu, rwkv_w0, rwkv_w_up, rwkv_a0, rwkv_a_up, rwkv_g_up, rwkv_k_k, rwkv_k_a,
              rwkv_r_k, rwkv_gn_g, rwkv_gn_b, w_router, b_router, w_gate_up, b_gate_up,
              w_down, b_down):
    B, S, _ = x.shape
    M = mem.shape[1]
    for l in range(DEPTH):
        h = rmsnorm(x, g_mix[l])
        p = h @ w_in[l]
        pq, pk, pv, p_rwkv, p_mq = jnp.split(
            p, [MOBA_W, 2 * MOBA_W, 3 * MOBA_W, 3 * MOBA_W + RWKV_COLS], axis=-1)
        y_moba = moba_attention(pq.reshape(B, S, MOBA_HEADS, HEAD_DIM),
                                pk.reshape(B, S, MOBA_HEADS, HEAD_DIM),
                                pv.reshape(B, S, MOBA_HEADS, HEAD_DIM), rel_bias)
        y_rwkv = rwkv7_time_mix(p_rwkv, rwkv_mu[l], rwkv_w0[l], rwkv_w_up[l], rwkv_a0[l],
                                rwkv_a_up[l], rwkv_g_up[l], rwkv_k_k[l], rwkv_k_a[l],
                                rwkv_r_k[l], rwkv_gn_g[l], rwkv_gn_b[l])
        mkv = rmsnorm(mem, g_mem[l]) @ w_mem_kv[l]
        mk, mv = jnp.split(mkv, 2, axis=-1)
        y_mem = memory_attention(p_mq.reshape(B, S, MEM_HEADS, HEAD_DIM),
                                 mk.reshape(B, M, MEM_HEADS, HEAD_DIM),
                                 mv.reshape(B, M, MEM_HEADS, HEAD_DIM))
        x = x + jnp.concatenate([y_moba, y_rwkv, y_mem], axis=-1) @ w_out[l]
        x = x + moe_ffn(rmsnorm(x, g_ffn[l]), w_router[l], b_router[l], w_gate_up[l],
                        b_gate_up[l], w_down[l], b_down[l])
    return rmsnorm(x, g_final)
```

```cpp
#include <hip/hip_runtime.h>
#include <hip/hip_cooperative_groups.h>
#include <cstdio>
#include <cstdint>
namespace cg = cooperative_groups;

#define LAS __attribute__((address_space(3)))
typedef unsigned short bf16_t;
typedef short bf16x8 __attribute__((ext_vector_type(8)));
typedef short s16x4 __attribute__((ext_vector_type(4)));
typedef float f32x2 __attribute__((ext_vector_type(2)));
typedef float f32x4 __attribute__((ext_vector_type(4)));
typedef float f32x16 __attribute__((ext_vector_type(16)));
typedef unsigned u32x2 __attribute__((ext_vector_type(2)));
typedef unsigned u32x4 __attribute__((ext_vector_type(4)));

constexpr int NB = 8, SEQ = 2048, DM = 1024, NTOK = NB * SEQ;
constexpr int INC = 2816;
constexpr int C_Q = 0, C_K = 384, C_V = 768, C_RW = 1152, C_MQ = 2560;
constexpr int RW_R = 0, RW_K = 384, RW_V = 768, RW_XW = 1152, RW_XA = 1216, RW_XG = 1280;
constexpr int NMEM = 256, NEXP = 32, TOPK = 4, NASSIGN = NTOK * TOPK;
constexpr int DUMMY_ROW = NASSIGN;
constexpr int NTHREADS = 512;

constexpr size_t MiB = 1u << 20;
constexpr size_t WS_CTL = 0;
constexpr size_t WS_WIN = 1 * MiB;
constexpr size_t WS_WOUT = 7 * MiB;
constexpr size_t WS_WMKV = 9 * MiB;
constexpr size_t WS_LORA = 10 * MiB;
constexpr size_t WS_RS1 = 11 * MiB;
constexpr size_t WS_XPART = 12 * MiB;
constexpr size_t WS_KM = 13 * MiB;
constexpr size_t WS_TOPW = 14 * MiB;
constexpr size_t WS_LIST = 15 * MiB;
constexpr size_t WS_MEMB = 17 * MiB;
constexpr size_t WS_MKV = 21 * MiB;
constexpr size_t WS_XB = 24 * MiB;
constexpr size_t WS_P = 56 * MiB;
constexpr size_t WS_Y = 144 * MiB;
constexpr size_t WS_X1B = 176 * MiB;
constexpr size_t WS_WGU = 208 * MiB;
constexpr size_t WS_WDN = 336 * MiB;
constexpr size_t WS_HMID = 400 * MiB;
constexpr size_t WS_YE = 530 * MiB;
constexpr size_t WS_RW = 660 * MiB;
constexpr size_t WS_END = 760 * MiB;

constexpr int RING_BYTES = 131072;
constexpr int XTRA_OFF = RING_BYTES;
constexpr int LDS_BYTES = 152 * 1024;

__device__ __forceinline__ unsigned f2bf(float f) { unsigned u = __builtin_bit_cast(unsigned, f); return (u + 0x7fffu + ((u >> 16) & 1u)) >> 16; }
__device__ __forceinline__ unsigned pk2(float lo, float hi) { return f2bf(lo) | (f2bf(hi) << 16); }
__device__ __forceinline__ float bf2f(unsigned short h) { return __builtin_bit_cast(float, (unsigned)h << 16); }
__device__ __forceinline__ float bflo(unsigned w) { return __builtin_bit_cast(float, w << 16); }
__device__ __forceinline__ float bfhi(unsigned w) { return __builtin_bit_cast(float, w & 0xffff0000u); }
__device__ __forceinline__ float wave_sum(float v) {
#pragma unroll
    for (int o = 32; o >= 1; o >>= 1) v += __shfl_xor(v, o);
    return v;
}

struct Params { const float* in[27]; float* out; unsigned char* ws; };
enum { I_X = 0, I_MEM, I_WIN, I_WOUT, I_WMKV, I_GMIX, I_GMEM, I_GFFN, I_GFIN, I_RELB, I_MU, I_W0, I_WUP, I_A0, I_AUP, I_GUP, I_KK, I_KA, I_RK, I_GNG, I_GNB, I_WR, I_BR, I_WGU, I_BGU, I_WDN, I_BDN };

namespace pg8 {
constexpr int BM = 256, BK = 64, HALF = 128, HTB = HALF * BK * 2, NXCD = 8, WGM = 8;
__host__ __device__ __forceinline__ int lds_byte(int r, int c) { const int st = (r >> 4) * 2 + (c >> 5), rr = r & 15, cc = c & 31, ob = rr * 64 + cc * 2; return st * 1024 + (ob ^ (((ob >> 9) & 1) << 5)); }
__host__ __device__ __forceinline__ void stage_rc(int b, int& R, int& C) { const int st = b / 1024, sb = b % 1024, swz = sb ^ (((sb >> 9) & 1) << 5); R = (st >> 1) * 16 + swz / 64; C = (st & 1) * 32 + (swz % 64) / 2; }
__host__ __device__ __forceinline__ int perm32(int rho) { const int n = rho >> 4, i = rho & 15; return 8 * (i >> 2) + 4 * n + (i & 3); }

struct Unit { int pm, pn, ti; };

__device__ __forceinline__ int xcd_remap(int L, int nwg) { const int q = nwg / NXCD, r = nwg % NXCD, xcd = L % NXCD, off = L / NXCD; return (xcd < r ? xcd * (q + 1) : r * (q + 1) + (xcd - r) * q) + off; }

struct StaticOrder {
    int nM, nN, nwg, G, c;
    __device__ void init(int M, int N, int G_, int c_) { nM = M / BM; nN = N / BM; nwg = nM * nN; G = G_; c = c_; }
    __device__ bool next(int i, Unit& u) const {
        const long L = (long)i * G + c; if (L >= nwg) return false;
        const int wgid = xcd_remap((int)L, nwg);
        const int nig = WGM * nN, gid = wgid / nig, fm = gid * WGM, gsz = (nM - fm) < WGM ? (nM - fm) : WGM;
        u.pm = fm + ((wgid % nig) % gsz); u.pn = (wgid % nig) / gsz; u.ti = 0; return true;
    }
    __device__ __forceinline__ int srcrow(const Unit&, int) const { return 0; }
};

struct TableOrder {
    const LAS int* meta;
    const LAS int* rows;
    int nunits; int mode;
    __device__ bool next(int i, Unit& u) const { if (i >= nunits) return false; u.pm = 0; u.pn = __builtin_amdgcn_readfirstlane(meta[i * 4]); u.ti = i; return true; }
    __device__ __forceinline__ int srcrow(const Unit& u, int r) const { const int a = rows[u.ti * 256 + r]; return mode == 0 ? (a < 0 ? 0 : (a >> 2)) : (a < 0 ? DUMMY_ROW : a); }
};

__device__ __forceinline__ unsigned cvt_pk_bf16(float lo, float hi) { unsigned r; asm volatile("v_cvt_pk_bf16_f32 %0, %1, %2" : "=v"(r) : "v"(lo), "v"(hi)); return r; }

template <bool GATHER, class Epi, class Sched>
__device__ __forceinline__ void gemm_phase(LAS unsigned char* lds, const bf16_t* A, const bf16_t* Bt, const int K, const Sched& S, const Epi& E) {
    int tid = threadIdx.x; asm volatile("" : "+v"(tid));
    const int wid = __builtin_amdgcn_readfirstlane(tid >> 6), lane = tid & 63, wr = wid >> 2, wc = wid & 3, fr = lane & 15, fq = lane >> 4;
    const int nt = K / BK;
    unsigned voffB[2]; int RA[2], CA[2];
#pragma unroll
    for (int i = 0; i < 2; ++i) { int R, C; stage_rc(tid * 16 + i * 8192, R, C); const int Rb = (R & ~31) + perm32(R & 31);
        RA[i] = R; CA[i] = C; voffB[i] = (unsigned)(Rb * K + C) * 2u; }
    const size_t kstep = (size_t)(BK * 2);
    const size_t hstep = (size_t)HALF * K * 2;
    const size_t tstep = 2 * hstep;
    const unsigned ldsw = (unsigned)wid * 1024u;
    const int aoff = lds_byte(wr * 64 + fr, fq * 8), boff = lds_byte(wc * 32 + fr, fq * 8);
    unsigned vC[2][2], vN[2][2];
#define PG8_SA(b, h) (((b) * 2 + (h)) * HTB)
#define PG8_SB(b, h) ((4 + (b) * 2 + (h)) * HTB)
#define PG8_STAGE(bufoff, gbase, voff) do { _Pragma("unroll") for (int _i = 0; _i < 2; ++_i) \
        __builtin_amdgcn_global_load_lds((const unsigned*)((const char*)(gbase) + (voff)[_i]), (LAS unsigned*)(lds + (bufoff) + ldsw + _i * 8192), 16, 0, 0); } while (0)
#define PG8_LDA(dst, b, h) do { _Pragma("unroll") for (int m = 0; m < 4; ++m) _Pragma("unroll") for (int k = 0; k < 2; ++k) dst[m][k] = *(const LAS bf16x8*)(lds + PG8_SA(b, h) + aoff + m * 2048 + k * 1024); } while (0)
#define PG8_LDB(dst, b, h) do { _Pragma("unroll") for (int n = 0; n < 2; ++n) _Pragma("unroll") for (int k = 0; k < 2; ++k) dst[n][k] = *(const LAS bf16x8*)(lds + PG8_SB(b, h) + boff + n * 2048 + k * 1024); } while (0)
#define PG8_MMA(ai, bj, At, Bt_) do { __builtin_amdgcn_s_setprio(1); _Pragma("unroll") for (int m = 0; m < 4; ++m) _Pragma("unroll") for (int n = 0; n < 2; ++n) _Pragma("unroll") for (int k = 0; k < 2; ++k) \
        acc[ai][bj][m][n] = __builtin_amdgcn_mfma_f32_16x16x32_bf16(Bt_[n][k], At[m][k], acc[ai][bj][m][n], 0, 0, 0); __builtin_amdgcn_s_setprio(0); } while (0)
#define PG8_WAIT_V(n) asm volatile("s_waitcnt vmcnt(" #n ")" ::: "memory")
#define PG8_WAIT_L(n) asm volatile("s_waitcnt lgkmcnt(" #n ")" ::: "memory")
#define PG8_BAR __builtin_amdgcn_s_barrier()
#define PG8_SCHED __builtin_amdgcn_sched_barrier(0)
#define PG8_SETV(dst, u) do { _Pragma("unroll") for (int _h = 0; _h < 2; ++_h) _Pragma("unroll") for (int _i = 0; _i < 2; ++_i) \
        dst[_h][_i] = GATHER ? (unsigned)(S.srcrow(u, _h * HALF + RA[_i]) * K + CA[_i]) * 2u : (unsigned)((_h * HALF + RA[_i]) * K + CA[_i]) * 2u; } while (0)
    Unit cur, nxt; int ui = 0;
    if (!S.next(0, cur)) return;
    f32x4 acc[2][2][4][2];
#pragma unroll
    for (int a = 0; a < 2; ++a)
#pragma unroll
        for (int b = 0; b < 2; ++b)
#pragma unroll
            for (int m = 0; m < 4; ++m)
#pragma unroll
                for (int n = 0; n < 2; ++n) acc[a][b][m][n] = (f32x4){0.f, 0.f, 0.f, 0.f};
    bf16x8 At[4][2], B0[2][2], B1[2][2];
    const char* cA = GATHER ? (const char*)A : (const char*)A + (size_t)cur.pm * tstep; const char* cB = (const char*)Bt + (size_t)cur.pn * tstep;
    PG8_SETV(vC, cur);
    if (GATHER) PG8_WAIT_L(0);
    PG8_STAGE(PG8_SB(0, 0), cB, voffB); PG8_STAGE(PG8_SB(0, 1), cB + hstep, voffB); PG8_STAGE(PG8_SA(0, 0), cA, vC[0]); PG8_STAGE(PG8_SA(0, 1), cA, vC[1]);
    if (wr == 1) PG8_BAR;
    PG8_WAIT_V(2); PG8_BAR;
    PG8_STAGE(PG8_SB(1, 0), cB + kstep, voffB); PG8_STAGE(PG8_SA(1, 0), cA + kstep, vC[0]); PG8_STAGE(PG8_SB(1, 1), cB + hstep + kstep, voffB);
    PG8_WAIT_V(6); PG8_BAR;
    for (;;) {
        const bool has_next = S.next(ui + 1, nxt);
        const char* nA = GATHER ? (const char*)A : (has_next ? (const char*)A + (size_t)nxt.pm * tstep : cA); const char* nB = has_next ? (const char*)Bt + (size_t)nxt.pn * tstep : cB;
        if (GATHER) { if (has_next) { PG8_SETV(vN, nxt); } else {
#pragma unroll
            for (int h = 0; h < 2; ++h)
#pragma unroll
                for (int i = 0; i < 2; ++i) vN[h][i] = vC[h][i]; } }
        for (int t = 0; t < nt; t += 2) {
            const bool last = (t == nt - 2);
            const char* a1 = cA + (size_t)(t + 1) * kstep;
            const char* a2 = last ? nA : cA + (size_t)(t + 2) * kstep; const char* b2 = last ? nB : cB + (size_t)(t + 2) * kstep;
            const char* a3 = a2 + kstep; const char* b3 = b2 + kstep;
            unsigned v2[2][2];
#pragma unroll
            for (int h = 0; h < 2; ++h)
#pragma unroll
                for (int i = 0; i < 2; ++i) v2[h][i] = (GATHER && last) ? vN[h][i] : vC[h][i];
            PG8_LDB(B0, 0, 0); PG8_LDB(B1, 0, 1); PG8_SCHED; PG8_LDA(At, 0, 0); PG8_STAGE(PG8_SA(1, 1), a1, vC[1]);
            PG8_WAIT_V(8); PG8_WAIT_L(0); PG8_BAR; PG8_MMA(0, 0, At, B0); PG8_MMA(0, 1, At, B1); PG8_BAR; PG8_SCHED;
            PG8_LDA(At, 0, 1); PG8_STAGE(PG8_SB(0, 0), b2, voffB); PG8_STAGE(PG8_SB(0, 1), b2 + hstep, voffB); PG8_STAGE(PG8_SA(0, 0), a2, v2[0]);
            PG8_WAIT_V(8); PG8_WAIT_L(0); PG8_BAR; PG8_MMA(1, 0, At, B0); PG8_MMA(1, 1, At, B1); PG8_BAR; PG8_SCHED;
            PG8_LDB(B0, 1, 0); PG8_LDB(B1, 1, 1); PG8_SCHED; PG8_LDA(At, 1, 0); PG8_STAGE(PG8_SA(0, 1), a2, v2[1]);
            PG8_WAIT_V(8); PG8_WAIT_L(0); PG8_BAR; PG8_MMA(0, 0, At, B0); PG8_MMA(0, 1, At, B1); PG8_BAR; PG8_SCHED;
            PG8_LDA(At, 1, 1); PG8_STAGE(PG8_SB(1, 0), b3, voffB); PG8_STAGE(PG8_SB(1, 1), b3 + hstep, voffB); PG8_STAGE(PG8_SA(1, 0), a3, v2[0]);
            PG8_WAIT_V(8); PG8_WAIT_L(0); PG8_BAR; PG8_MMA(1, 0, At, B0); PG8_MMA(1, 1, At, B1); PG8_BAR; PG8_SCHED;
        }
        if (wr == 0) PG8_BAR;
        E(acc, cur, wr, wc, fr, fq);
        if (!has_next) break;
#pragma unroll
        for (int a = 0; a < 2; ++a)
#pragma unroll
            for (int b = 0; b < 2; ++b)
#pragma unroll
                for (int m = 0; m < 4; ++m)
#pragma unroll
                    for (int n = 0; n < 2; ++n) acc[a][b][m][n] = (f32x4){0.f, 0.f, 0.f, 0.f};
        cur = nxt; cA = nA; cB = nB; ++ui;
#pragma unroll
        for (int h = 0; h < 2; ++h)
#pragma unroll
            for (int i = 0; i < 2; ++i) vC[h][i] = vN[h][i];
        if (wr == 1) PG8_BAR;
    }
    PG8_WAIT_V(0);
    PG8_BAR;
#undef PG8_SA
#undef PG8_SB
#undef PG8_STAGE
#undef PG8_LDA
#undef PG8_LDB
#undef PG8_MMA
#undef PG8_WAIT_V
#undef PG8_WAIT_L
#undef PG8_BAR
#undef PG8_SCHED
#undef PG8_SETV
}
}
using pg8::Unit; using pg8::HALF; using pg8::BM; using pg8::cvt_pk_bf16;

struct EpiRowScaleBf16 {
    bf16_t* O; int ldc; const float* rs;
    __device__ __forceinline__ void operator()(const f32x4 (&acc)[2][2][4][2], const Unit& u, int wr, int wc, int fr, int fq) const {
        const int row0 = u.pm * BM + wr * 64 + fr, col0 = u.pn * BM + wc * 32 + 8 * fq;
#pragma unroll
        for (int ai = 0; ai < 2; ++ai)
#pragma unroll
            for (int m = 0; m < 4; ++m) { const int row = row0 + ai * HALF + m * 16; const float s = rs[row]; bf16_t* rowp = O + (size_t)row * ldc + col0;
#pragma unroll
                for (int bj = 0; bj < 2; ++bj) { const f32x4 v0 = acc[ai][bj][m][0] * s, v1 = acc[ai][bj][m][1] * s;
                    u32x4 w; w.x = cvt_pk_bf16(v0[0], v0[1]); w.y = cvt_pk_bf16(v0[2], v0[3]); w.z = cvt_pk_bf16(v1[0], v1[1]); w.w = cvt_pk_bf16(v1[2], v1[3]);
                    *(u32x4*)(rowp + bj * HALF) = w; } }
    }
};

struct EpiResidual {
    const float* X; float* X1; bf16_t* X1B;
    __device__ __forceinline__ void operator()(const f32x4 (&acc)[2][2][4][2], const Unit& u, int wr, int wc, int fr, int fq) const {
        const int row0 = u.pm * BM + wr * 64 + fr, col0 = u.pn * BM + wc * 32 + 8 * fq;
#pragma unroll
        for (int ai = 0; ai < 2; ++ai)
#pragma unroll
            for (int m = 0; m < 4; ++m) { const size_t ro = (size_t)(row0 + ai * HALF + m * 16) * DM + col0;
#pragma unroll
                for (int bj = 0; bj < 2; ++bj) { const f32x4 x0 = *(const f32x4*)(X + ro + bj * HALF), x1 = *(const f32x4*)(X + ro + bj * HALF + 4);
                    const f32x4 v0 = acc[ai][bj][m][0] + x0, v1 = acc[ai][bj][m][1] + x1;
                    *(f32x4*)(X1 + ro + bj * HALF) = v0; *(f32x4*)(X1 + ro + bj * HALF + 4) = v1;
                    u32x4 w; w.x = cvt_pk_bf16(v0[0], v0[1]); w.y = cvt_pk_bf16(v0[2], v0[3]); w.z = cvt_pk_bf16(v1[0], v1[1]); w.w = cvt_pk_bf16(v1[2], v1[3]);
                    *(u32x4*)(X1B + ro + bj * HALF) = w; } }
    }
};

struct EpiSwiglu {
    const LAS int* meta; const LAS int* rows; const float* rs2; const float* bgu; bf16_t* H;
    __device__ __forceinline__ void operator()(const f32x4 (&acc)[2][2][4][2], const Unit& u, int wr, int wc, int fr, int fq) const {
        const int e = __builtin_amdgcn_readfirstlane(meta[u.ti * 4 + 1]), pnl = __builtin_amdgcn_readfirstlane(meta[u.ti * 4 + 2]);
        const int j0 = pnl * 128 + wc * 32 + 8 * fq;
        const float* bp = bgu + (size_t)e * 2048 + 2 * j0;
        float bg[8], bu[8];
#pragma unroll
        for (int q = 0; q < 4; ++q) { const f32x4 t = *(const f32x4*)(bp + 4 * q); bg[2 * q] = t[0]; bu[2 * q] = t[1]; bg[2 * q + 1] = t[2]; bu[2 * q + 1] = t[3]; }
#pragma unroll
        for (int ai = 0; ai < 2; ++ai)
#pragma unroll
            for (int m = 0; m < 4; ++m) { const int r = ai * HALF + wr * 64 + m * 16 + fr; const int aid = rows[u.ti * 256 + r];
                const float s = rs2[aid < 0 ? 0 : (aid >> 2)]; bf16_t* rowp = H + (size_t)(aid < 0 ? DUMMY_ROW : aid) * DM + j0;
                float o[8];
#pragma unroll
                for (int n = 0; n < 2; ++n)
#pragma unroll
                    for (int q = 0; q < 4; ++q) { float g = acc[ai][0][m][n][q] * s + bg[4 * n + q], up = acc[ai][1][m][n][q] * s + bu[4 * n + q];
                        g = fminf(g, 7.0f); up = fminf(fmaxf(up, -7.0f), 7.0f);
                        const float glu = g * __builtin_amdgcn_rcpf(1.0f + __expf(-1.702f * g));
                        o[4 * n + q] = (up + 1.0f) * glu; }
                u32x4 w; w.x = cvt_pk_bf16(o[0], o[1]); w.y = cvt_pk_bf16(o[2], o[3]); w.z = cvt_pk_bf16(o[4], o[5]); w.w = cvt_pk_bf16(o[6], o[7]);
                *(u32x4*)rowp = w; }
    }
};

struct EpiDown {
    const LAS int* meta; const LAS int* rows; const float* topw; const float* bdn; bf16_t* Y;
    __device__ __forceinline__ void operator()(const f32x4 (&acc)[2][2][4][2], const Unit& u, int wr, int wc, int fr, int fq) const {
        const int e = __builtin_amdgcn_readfirstlane(meta[u.ti * 4 + 1]), pnl = __builtin_amdgcn_readfirstlane(meta[u.ti * 4 + 2]);
        const int col0 = pnl * BM + wc * 32 + 8 * fq;
        f32x4 bv[2][2];
#pragma unroll
        for (int bj = 0; bj < 2; ++bj)
#pragma unroll
            for (int n = 0; n < 2; ++n) bv[bj][n] = *(const f32x4*)(bdn + (size_t)e * DM + col0 + bj * HALF + 4 * n);
#pragma unroll
        for (int ai = 0; ai < 2; ++ai)
#pragma unroll
            for (int m = 0; m < 4; ++m) { const int r = ai * HALF + wr * 64 + m * 16 + fr; const int aid = rows[u.ti * 256 + r];
                const float s = topw[aid < 0 ? 0 : aid]; bf16_t* rowp = Y + (size_t)(aid < 0 ? DUMMY_ROW : aid) * DM + col0;
#pragma unroll
                for (int bj = 0; bj < 2; ++bj) { const f32x4 v0 = (acc[ai][bj][m][0] + bv[bj][0]) * s, v1 = (acc[ai][bj][m][1] + bv[bj][1]) * s;
                    u32x4 w; w.x = cvt_pk_bf16(v0[0], v0[1]); w.y = cvt_pk_bf16(v0[2], v0[3]); w.z = cvt_pk_bf16(v1[0], v1[1]); w.w = cvt_pk_bf16(v1[2], v1[3]);
                    *(u32x4*)(rowp + bj * HALF) = w; } }
    }
};

struct Frame {
    LAS unsigned char* lds; int tid, lane, wave, G, bid;
    const float* const* in; float* out; unsigned char* ws;
    __device__ __forceinline__ unsigned* ctl() const { return (unsigned*)(ws + WS_CTL); }
};

__device__ __forceinline__ void p0_rows(const Frame& F) {
    const float* x = F.in[I_X]; bf16_t* XB = (bf16_t*)(F.ws + WS_XB); float* RS1 = (float*)(F.ws + WS_RS1); float* XP = (float*)(F.ws + WS_XPART);
    LAS float* red = (LAS float*)F.lds;
    for (int g = F.bid; g < NTOK / 64; g += F.G) {
        float xs[16];
#pragma unroll
        for (int i = 0; i < 16; ++i) xs[i] = 0.f;
        for (int i = 0; i < 8; ++i) { const int row = g * 64 + F.wave * 8 + i; const float* xr = x + (size_t)row * DM;
            f32x4 v[4]; float ss = 0.f;
#pragma unroll
            for (int j = 0; j < 4; ++j) { v[j] = *(const f32x4*)(xr + 256 * j + 4 * F.lane); ss += v[j][0] * v[j][0] + v[j][1] * v[j][1] + v[j][2] * v[j][2] + v[j][3] * v[j][3]; }
            ss = wave_sum(ss); const float rs = rsqrtf(ss * (1.0f / DM) + 1e-5f);
            if (F.lane == 0) RS1[row] = rs;
#pragma unroll
            for (int j = 0; j < 4; ++j) { u32x2 w; w.x = pk2(v[j][0], v[j][1]); w.y = pk2(v[j][2], v[j][3]); *(u32x2*)(XB + (size_t)row * DM + 256 * j + 4 * F.lane) = w;
#pragma unroll
                for (int e = 0; e < 4; ++e) xs[4 * j + e] += rs * v[j][e]; } }
#pragma unroll
        for (int j = 0; j < 4; ++j)
#pragma unroll
            for (int e = 0; e < 4; ++e) red[F.wave * 1024 + 256 * j + 4 * F.lane + e] = xs[4 * j + e];
        __syncthreads();
        for (int c = F.tid; c < 1024; c += NTHREADS) { float s = 0.f;
#pragma unroll
            for (int w = 0; w < 8; ++w) s += red[w * 1024 + c];
            XP[(size_t)g * 1024 + c] = s; }
        __syncthreads();
    }
    const float* mem = F.in[I_MEM]; bf16_t* MB = (bf16_t*)(F.ws + WS_MEMB); float* RSM = (float*)(F.ws + WS_RS1 + 65536);
    for (int row = F.bid * 8 + F.wave; row < NB * NMEM; row += F.G * 8) { const float* xr = mem + (size_t)row * DM;
        f32x4 v[4]; float ss = 0.f;
#pragma unroll
        for (int j = 0; j < 4; ++j) { v[j] = *(const f32x4*)(xr + 256 * j + 4 * F.lane); ss += v[j][0] * v[j][0] + v[j][1] * v[j][1] + v[j][2] * v[j][2] + v[j][3] * v[j][3]; }
        ss = wave_sum(ss); if (F.lane == 0) RSM[row] = rsqrtf(ss * (1.0f / DM) + 1e-5f);
#pragma unroll
        for (int j = 0; j < 4; ++j) { u32x2 w; w.x = pk2(v[j][0], v[j][1]); w.y = pk2(v[j][2], v[j][3]); *(u32x2*)(MB + (size_t)row * DM + 256 * j + 4 * F.lane) = w; }
    }
}

struct TJob { const float* src; bf16_t* dst; const float* gk; int K, N, ntk, ntn, perm; };
__device__ __forceinline__ int tjob_destrow(const TJob& J, int n) { if (!J.perm) return n; const int j = n >> 1, up = n & 1; return (j >> 7) * 256 + up * 128 + (j & 127); }
__device__ __forceinline__ void tjob_load(const TJob& J, int tile, int tid, f32x4 (&v)[4]) {
    const int tk = tile % J.ntk, tn = tile / J.ntk; const int r = tid >> 5, c4 = (tid & 31) * 4;
#pragma unroll
    for (int p = 0; p < 4; ++p) { const int k = tk * 64 + p * 16 + r; f32x4 t = *(const f32x4*)(J.src + (size_t)k * J.N + tn * 128 + c4); if (J.gk) t = t * J.gk[k]; v[p] = t; }
}
__device__ __forceinline__ void tjob_store(const TJob& J, int tile, int tid, const f32x4 (&v)[4], LAS float* T  ) {
    const int tk = tile % J.ntk, tn = tile / J.ntk; const int r = tid >> 5, c4 = (tid & 31) * 4;
#pragma unroll
    for (int p = 0; p < 4; ++p)
#pragma unroll
        for (int e = 0; e < 4; ++e) T[(c4 + e) * 65 + p * 16 + r] = v[p][e];
    __syncthreads();
    const int n = tid >> 2, ks = (tid & 3) * 16;
    float f[16];
#pragma unroll
    for (int e = 0; e < 16; ++e) f[e] = T[n * 65 + ks + e];
    u32x4 w0, w1; w0.x = pk2(f[0], f[1]); w0.y = pk2(f[2], f[3]); w0.z = pk2(f[4], f[5]); w0.w = pk2(f[6], f[7]); w1.x = pk2(f[8], f[9]); w1.y = pk2(f[10], f[11]); w1.z = pk2(f[12], f[13]); w1.w = pk2(f[14], f[15]);
    bf16_t* d = J.dst + (size_t)tjob_destrow(J, tn * 128 + n) * J.K + tk * 64 + ks;
    *(u32x4*)d = w0; *(u32x4*)(d + 8) = w1;
    __syncthreads();
}
__device__ __forceinline__ void run_tjob(const Frame& F, const TJob& J, int expert_stride_src, int expert_stride_dst, int nexp) {
    const int per = J.ntk * J.ntn, total = per * nexp;
    LAS float* T = (LAS float*)F.lds;
    f32x4 v[4];
    int t = F.bid;
    TJob Jc = J;
    if (t < total) { Jc.src = J.src + (size_t)(t / per) * expert_stride_src; tjob_load(Jc, t % per, F.tid, v); }
    while (t < total) {
        const int e = t / per, tile = t % per; TJob Js = J; Js.src = J.src + (size_t)e * expert_stride_src; Js.dst = J.dst + (size_t)e * expert_stride_dst;
        f32x4 cur[4];
#pragma unroll
        for (int p = 0; p < 4; ++p) cur[p] = v[p];
        const int tn2 = t + F.G;
        if (tn2 < total) { TJob Jn = J; Jn.src = J.src + (size_t)(tn2 / per) * expert_stride_src; tjob_load(Jn, tn2 % per, F.tid, v); }
        tjob_store(Js, tile, F.tid, cur, T);
        t = tn2;
    }
}

__device__ __forceinline__ void p0_prologue(const Frame& F) {
    if (F.bid == 0 && F.tid < 64) F.ctl()[F.tid] = 0u;
    p0_rows(F);
    const float* const* in = F.in;
    { TJob J{in[I_WIN], (bf16_t*)(F.ws + WS_WIN), in[I_GMIX], 1024, INC, 16, INC / 128, 0}; run_tjob(F, J, 0, 0, 1); }
    { TJob J{in[I_WOUT], (bf16_t*)(F.ws + WS_WOUT), nullptr, 1024, 1024, 16, 8, 0}; run_tjob(F, J, 0, 0, 1); }
    { TJob J{in[I_WMKV], (bf16_t*)(F.ws + WS_WMKV), in[I_GMEM], 1024, 512, 16, 4, 0}; run_tjob(F, J, 0, 0, 1); }
    { TJob J{in[I_WUP], (bf16_t*)(F.ws + WS_LORA), nullptr, 64, 384, 1, 3, 0}; run_tjob(F, J, 0, 0, 1); }
    { TJob J{in[I_AUP], (bf16_t*)(F.ws + WS_LORA) + 384 * 64, nullptr, 64, 384, 1, 3, 0}; run_tjob(F, J, 0, 0, 1); }
    { TJob J{in[I_GUP], (bf16_t*)(F.ws + WS_LORA) + 2 * 384 * 64, nullptr, 128, 384, 2, 3, 0}; run_tjob(F, J, 0, 0, 1); }
    { TJob J{in[I_WGU], (bf16_t*)(F.ws + WS_WGU), in[I_GFFN], 1024, 2048, 16, 16, 1}; run_tjob(F, J, 1024 * 2048, 2048 * 1024, NEXP); }
    { TJob J{in[I_WDN], (bf16_t*)(F.ws + WS_WDN), nullptr, 1024, 1024, 16, 8, 0}; run_tjob(F, J, 1024 * 1024, 1024 * 1024, NEXP); }
}

__device__ __forceinline__ void kmean_task(const Frame& F) {
    const float* XP = (const float*)(F.ws + WS_XPART); const bf16_t* W = (const bf16_t*)(F.ws + WS_WIN) + (size_t)C_K * DM; float* KM = (float*)(F.ws + WS_KM);
    for (int o = (F.bid * 8 + F.wave) * 12; o < 64 * 384; o += F.G * 8 * 12) {
        const int n = o / 384;
        float xb[16];
#pragma unroll
        for (int i = 0; i < 16; ++i) xb[i] = 0.f;
#pragma unroll
        for (int q = 0; q < 4; ++q)
#pragma unroll
            for (int j = 0; j < 4; ++j) { const f32x4 t = *(const f32x4*)(XP + (size_t)(4 * n + q) * 1024 + 16 * F.lane + 4 * j); xb[4 * j] += t[0]; xb[4 * j + 1] += t[1]; xb[4 * j + 2] += t[2]; xb[4 * j + 3] += t[3]; }
        for (int i = 0; i < 12; ++i) { const int c = (o + i) % 384; const u32x4 w0 = *(const u32x4*)(W + (size_t)c * DM + 16 * F.lane), w1 = *(const u32x4*)(W + (size_t)c * DM + 16 * F.lane + 8);
            float s = xb[0] * bflo(w0.x) + xb[1] * bfhi(w0.x) + xb[2] * bflo(w0.y) + xb[3] * bfhi(w0.y) + xb[4] * bflo(w0.z) + xb[5] * bfhi(w0.z) + xb[6] * bflo(w0.w) + xb[7] * bfhi(w0.w)
                    + xb[8] * bflo(w1.x) + xb[9] * bfhi(w1.x) + xb[10] * bflo(w1.y) + xb[11] * bfhi(w1.y) + xb[12] * bflo(w1.z) + xb[13] * bfhi(w1.z) + xb[14] * bflo(w1.w) + xb[15] * bfhi(w1.w);
            s = wave_sum(s); if (F.lane == 0) KM[o + i] = s * (1.0f / 256.0f); }
    }
}

__device__ __forceinline__ void router_phase(const Frame& F) {
    const float* X1 = F.out; const float* wr = F.in[I_WR]; const float* gf = F.in[I_GFFN]; const float* br = F.in[I_BR];
    float* RS2 = (float*)(F.ws + WS_RS1 + 131072); float* TOPW = (float*)(F.ws + WS_TOPW); int* LIST = (int*)(F.ws + WS_LIST); unsigned* CNT = F.ctl();
    LAS float* W = (LAS float*)F.lds;
    LAS int* lcnt = (LAS int*)(F.lds + XTRA_OFF); LAS int* lbase = lcnt + 32; LAS int* lexp = lcnt + 64; LAS int* lrank = lcnt + 64 + 256;
    for (int i = F.tid; i < 1024 * 32 / 4; i += NTHREADS) { f32x4 t = *(const f32x4*)(wr + 4 * i); t = t * gf[i >> 3]; *(LAS f32x4*)(W + 4 * i) = t; }
    const int e = F.lane & 31, kh = F.lane >> 5;
    const float be = br[e];
    for (int g = F.bid; g < NTOK / 64; g += F.G) {
        if (F.tid < 32) lcnt[F.tid] = 0;
        __syncthreads();
        const int t0 = g * 64 + F.wave * 8;
        float acc[8], ss[8];
#pragma unroll
        for (int t = 0; t < 8; ++t) { acc[t] = 0.f; ss[t] = 0.f; }
        for (int k4 = 0; k4 < 128; ++k4) { const int k = kh * 512 + 4 * k4;
            const float w0 = W[(k + 0) * 32 + e], w1 = W[(k + 1) * 32 + e], w2 = W[(k + 2) * 32 + e], w3 = W[(k + 3) * 32 + e];
#pragma unroll
            for (int t = 0; t < 8; ++t) { const f32x4 xv = *(const f32x4*)(X1 + (size_t)(t0 + t) * DM + k);
                acc[t] += xv[0] * w0 + xv[1] * w1 + xv[2] * w2 + xv[3] * w3; ss[t] += xv[0] * xv[0] + xv[1] * xv[1] + xv[2] * xv[2] + xv[3] * xv[3]; } }
#pragma unroll
        for (int t = 0; t < 8; ++t) { acc[t] += __shfl_xor(acc[t], 32); ss[t] += __shfl_xor(ss[t], 32); }
#pragma unroll
        for (int t = 0; t < 8; ++t) {
            const float rs = rsqrtf(ss[t] * (1.0f / DM) + 1e-5f);
            float lg = acc[t] * rs + be;
            float tv[4]; int te[4];
#pragma unroll
            for (int r = 0; r < 4; ++r) { float v = lg; int idx = e;
#pragma unroll
                for (int o = 16; o >= 1; o >>= 1) { const float ov = __shfl_xor(v, o); const int oi = __shfl_xor(idx, o); if (ov > v || (ov == v && oi < idx)) { v = ov; idx = oi; } }
                tv[r] = v; te[r] = idx; if (e == idx) lg = -INFINITY; }
            const float e1 = __expf(tv[1] - tv[0]), e2 = __expf(tv[2] - tv[0]), e3 = __expf(tv[3] - tv[0]); const float inv = 1.0f / (1.0f + e1 + e2 + e3);
            if (F.lane < 4) { const int k = F.lane; const float w = (k == 0 ? 1.0f : k == 1 ? e1 : k == 2 ? e2 : e3) * inv; const int ek = (k == 0 ? te[0] : k == 1 ? te[1] : k == 2 ? te[2] : te[3]);
                const int a = (F.wave * 8 + t) * 4 + k; TOPW[(size_t)(g * 64) * 4 + a] = w;
                lexp[a] = ek; lrank[a] = __hip_atomic_fetch_add(&lcnt[ek], 1, __ATOMIC_RELAXED, __HIP_MEMORY_SCOPE_WORKGROUP); }
            if (F.lane == 0) RS2[t0 + t] = rs;
        }
        __syncthreads();
        if (F.tid < 32) lbase[F.tid] = (int)atomicAdd(&CNT[F.tid], (unsigned)lcnt[F.tid]);
        __syncthreads();
        if (F.tid < 256) { const int ek = lexp[F.tid]; LIST[(size_t)ek * NTOK + lbase[ek] + lrank[F.tid]] = g * 256 + F.tid; }
        __syncthreads();
    }
}

constexpr int MAXU = 16;
struct UTab { LAS int* meta; LAS int* rows; LAS int* pre; int nunits; };
__device__ __forceinline__ UTab build_unit_table(const Frame& F, int nN) {
    UTab T; T.pre = (LAS int*)(F.lds + XTRA_OFF); T.meta = T.pre + 64; T.rows = T.meta + MAXU * 4;
    const unsigned* CNT = F.ctl(); const int* LIST = (const int*)(F.ws + WS_LIST);
    if (F.tid == 0) { int s = 0; for (int e = 0; e < NEXP; ++e) { T.pre[e] = s; s += ((int)CNT[e] + 255) >> 8; } T.pre[NEXP] = s; }
    __syncthreads();
    const int RT = T.pre[NEXP], U = RT * nN;
    const int vcu = (F.G % 8 == 0) ? F.bid : F.bid;
    int nu = 0;
    for (int i = 0; i < MAXU; ++i) { const int L = i * F.G + vcu; if (L >= U) break;
        const int wgid = pg8::xcd_remap(L, U); const int rtg = wgid / nN, pn = wgid % nN;
        int e = 0; for (int q = 1; q < NEXP; ++q) if (T.pre[q] <= rtg) e = q;
        const int r = rtg - T.pre[e]; const int cnt = (int)CNT[e];
        if (F.tid == 0) { T.meta[i * 4] = e * nN + pn; T.meta[i * 4 + 1] = e; T.meta[i * 4 + 2] = pn; T.meta[i * 4 + 3] = r; }
        if (F.tid < 256) { const int idx = r * 256 + F.tid; T.rows[i * 256 + F.tid] = idx < cnt ? LIST[(size_t)e * NTOK + idx] : -1; }
        nu = i + 1; }
    __syncthreads();
    T.nunits = nu; return T;
}

__device__ __forceinline__ void final_phase(const Frame& F) {
    const bf16_t* YE = (const bf16_t*)(F.ws + WS_YE); const float* gfin = F.in[I_GFIN]; float* out = F.out;
    for (int row = F.bid * 8 + F.wave; row < NTOK; row += F.G * 8) {
        float v[16];
#pragma unroll
        for (int j = 0; j < 4; ++j) { const f32x4 t = *(const f32x4*)(out + (size_t)row * DM + 256 * j + 4 * F.lane); v[4 * j] = t[0]; v[4 * j + 1] = t[1]; v[4 * j + 2] = t[2]; v[4 * j + 3] = t[3]; }
#pragma unroll
        for (int k = 0; k < 4; ++k)
#pragma unroll
            for (int j = 0; j < 4; ++j) { const u32x2 w = *(const u32x2*)(YE + (size_t)(row * 4 + k) * DM + 256 * j + 4 * F.lane); v[4 * j] += bflo(w.x); v[4 * j + 1] += bfhi(w.x); v[4 * j + 2] += bflo(w.y); v[4 * j + 3] += bfhi(w.y); }
        float ss = 0.f;
#pragma unroll
        for (int i = 0; i < 16; ++i) ss += v[i] * v[i];
        ss = wave_sum(ss); const float rs = rsqrtf(ss * (1.0f / DM) + 1e-5f);
#pragma unroll
        for (int j = 0; j < 4; ++j) { const f32x4 g = *(const f32x4*)(gfin + 256 * j + 4 * F.lane); f32x4 o; o[0] = v[4 * j] * rs * g[0]; o[1] = v[4 * j + 1] * rs * g[1]; o[2] = v[4 * j + 2] * rs * g[2]; o[3] = v[4 * j + 3] * rs * g[3];
            *(f32x4*)(out + (size_t)row * DM + 256 * j + 4 * F.lane) = o; }
    }
}
__device__ __forceinline__ int crow(int r, int hi) { return (r & 3) + 8 * (r >> 2) + 4 * hi; }
constexpr int AT_KB = 0, AT_VB = 2 * 9216, AT_LUT = 4 * 9216, AT_UNIT = AT_LUT + 512;
constexpr float LOG2E = 1.4426950408889634f;

template <int MODE  >
__device__ __forceinline__ void attn_unit(const Frame& F, int b, int h, int qb) {
    const int lane = F.lane, wid = F.wave, r32 = lane & 31, hi = lane >> 5;
    const bf16_t* P = (const bf16_t*)(F.ws + WS_P); const bf16_t* MKV = (const bf16_t*)(F.ws + WS_MKV); bf16_t* Y = (bf16_t*)(F.ws + WS_Y);
    const size_t tok0 = (size_t)b * SEQ + (size_t)qb * 256;
    const bf16_t* Qp = P + tok0 * INC + (MODE ? C_Q : C_MQ) + h * 64;
    const bf16_t* Kb = MODE ? P + (size_t)b * SEQ * INC + C_K + h * 64 : MKV + (size_t)b * NMEM * 512 + h * 64;
    const bf16_t* Vb = MODE ? P + (size_t)b * SEQ * INC + C_V + h * 64 : MKV + (size_t)b * NMEM * 512 + 256 + h * 64;
    const int pkv = MODE ? INC : 512;
    const int nt = MODE ? 4 + 4 * qb : 4;
    LAS unsigned char* lds = F.lds;
    LAS float* LUT = (LAS float*)(lds + AT_LUT);
    auto tile_row = [&](int t) -> int { return MODE ? (t < 4 ? qb * 256 + 64 * t : 64 * (t - 4)) : 64 * t; };
    bf16x8 qf[4];
#pragma unroll
    for (int s = 0; s < 4; ++s) qf[s] = *(const bf16x8*)(Qp + (size_t)(32 * wid + r32) * INC + 16 * s + 8 * hi);
    unsigned selmask = 0xffu;
    if (MODE) {
        if (F.tid < 128) { const int n = F.tid; int bk = n; if (n >= 16) { bk = 16 + (int)(__logf((float)n * (1.0f / 16.0f)) / __logf(8.0f) * 16.0f); bk = bk > 31 ? 31 : bk; }
            const float* rb = F.in[I_RELB]; LUT[n] = (rb[bk * 6 + h] - rb[31 * 6 + h]) * LOG2E; }
        if (qb >= 4) {
            const float* KM = (const float*)(F.ws + WS_KM) + (size_t)(b * 8) * 384 + h * 64;
            float gate[7];
#pragma unroll
            for (int n = 0; n < 7; ++n) { float g = 0.f;
                if (n < qb) {
#pragma unroll
                    for (int s = 0; s < 4; ++s) { const f32x4 k0 = *(const f32x4*)(KM + n * 384 + 16 * s + 8 * hi), k1 = *(const f32x4*)(KM + n * 384 + 16 * s + 8 * hi + 4);
                        g += bf2f((unsigned short)qf[s][0]) * k0[0] + bf2f((unsigned short)qf[s][1]) * k0[1] + bf2f((unsigned short)qf[s][2]) * k0[2] + bf2f((unsigned short)qf[s][3]) * k0[3]
                           + bf2f((unsigned short)qf[s][4]) * k1[0] + bf2f((unsigned short)qf[s][5]) * k1[1] + bf2f((unsigned short)qf[s][6]) * k1[2] + bf2f((unsigned short)qf[s][7]) * k1[3]; }
                    g += __shfl_xor(g, 32);
                } else g = -INFINITY;
                gate[n] = g; }
            selmask = 0u;
#pragma unroll
            for (int r = 0; r < 3; ++r) { float bv = -INFINITY; int bi = 0;
#pragma unroll
                for (int n = 0; n < 7; ++n) { const bool take = !((selmask >> n) & 1u) && (gate[n] > bv); bv = take ? gate[n] : bv; bi = take ? n : bi; }
                selmask |= 1u << bi; }
        } else selmask = (1u << qb) - 1u;
    }
    u32x4 kreg, vreg;
    auto gload = [&](int t) { const size_t ro = (size_t)(tile_row(t) + lane) * pkv + 8 * wid; kreg = *(const u32x4*)(Kb + ro); vreg = *(const u32x4*)(Vb + ro); };
    auto lwrite = [&](int buf) {
        *(LAS u32x4*)(lds + AT_KB + buf * 9216 + lane * 144 + 16 * wid) = kreg;
        LAS unsigned short* vt = (LAS unsigned short*)(lds + AT_VB + buf * 9216) + (8 * wid) * 72 + lane;
        vt[0 * 72] = (unsigned short)(vreg.x & 0xffff); vt[1 * 72] = (unsigned short)(vreg.x >> 16); vt[2 * 72] = (unsigned short)(vreg.y & 0xffff); vt[3 * 72] = (unsigned short)(vreg.y >> 16);
        vt[4 * 72] = (unsigned short)(vreg.z & 0xffff); vt[5 * 72] = (unsigned short)(vreg.z >> 16); vt[6 * 72] = (unsigned short)(vreg.w & 0xffff); vt[7 * 72] = (unsigned short)(vreg.w >> 16); };
    gload(0); lwrite(0);
    __syncthreads();
    float m_run = -INFINITY, l_run = 0.f;
    f32x16 o0 = {}, o1 = {};
    const int qrel = 32 * wid + r32;
    constexpr float SC = 0.125f * LOG2E;
#pragma unroll 1
    for (int t = 0; t < nt; ++t) {
        if (t + 1 < nt) gload(t + 1);
        const int buf = t & 1;
        bool active = true; int nblk = 0, jb = t;
        if (MODE) { if (t < 4) active = (64 * t <= 32 * wid + 31); else { nblk = (t - 4) >> 2; jb = (t - 4) & 3; } }
        if (active) {
            const LAS unsigned char* kb = lds + AT_KB + buf * 9216;
            f32x16 s0 = {}, s1 = {};
#pragma unroll
            for (int s = 0; s < 4; ++s) { const bf16x8 k0 = *(const LAS bf16x8*)(kb + r32 * 144 + (16 * s + 8 * hi) * 2), k1 = *(const LAS bf16x8*)(kb + (32 + r32) * 144 + (16 * s + 8 * hi) * 2);
                s0 = __builtin_amdgcn_mfma_f32_32x32x16_bf16(k0, qf[s], s0, 0, 0, 0); s1 = __builtin_amdgcn_mfma_f32_32x32x16_bf16(k1, qf[s], s1, 0, 0, 0); }
            if (MODE) {
                if (t < 4) {
#pragma unroll
                    for (int r = 0; r < 16; ++r) { const int d0 = qrel - (64 * t + crow(r, hi)), d1 = d0 - 32;
                        s0[r] = d0 >= 0 ? s0[r] * SC + LUT[d0 > 127 ? 127 : d0] : -INFINITY; s1[r] = d1 >= 0 ? s1[r] * SC + LUT[d1 > 127 ? 127 : d1] : -INFINITY; }
                } else {
                    const bool sel = (selmask >> nblk) & 1u;
                    if (nblk == qb - 1 && jb >= 2) {
#pragma unroll
                        for (int r = 0; r < 16; ++r) { const int d0 = 256 + qrel - (64 * jb + crow(r, hi)), d1 = d0 - 32;
                            s0[r] = sel ? s0[r] * SC + LUT[d0 > 127 ? 127 : d0] : -INFINITY; s1[r] = sel ? s1[r] * SC + LUT[d1 > 127 ? 127 : d1] : -INFINITY; }
                    } else {
#pragma unroll
                        for (int r = 0; r < 16; ++r) { s0[r] = sel ? s0[r] * SC : -INFINITY; s1[r] = sel ? s1[r] * SC : -INFINITY; }
                    }
                }
            } else {
#pragma unroll
                for (int r = 0; r < 16; ++r) { s0[r] *= SC; s1[r] *= SC; }
            }
            float mx = s0[0];
#pragma unroll
            for (int r = 1; r < 16; ++r) mx = fmaxf(mx, s0[r]);
#pragma unroll
            for (int r = 0; r < 16; ++r) mx = fmaxf(mx, s1[r]);
            mx = fmaxf(mx, __shfl_xor(mx, 32));
            const float m_new = fmaxf(m_run, mx);
            const float msafe = (m_new == -INFINITY) ? 0.f : m_new;
            const float alpha = __builtin_amdgcn_exp2f(m_run - msafe);
            float ps = 0.f;
#pragma unroll
            for (int r = 0; r < 16; ++r) { s0[r] = __builtin_amdgcn_exp2f(s0[r] - msafe); s1[r] = __builtin_amdgcn_exp2f(s1[r] - msafe); ps += s0[r] + s1[r]; }
            l_run = l_run * alpha + ps; m_run = m_new;
#pragma unroll
            for (int r = 0; r < 16; ++r) { o0[r] *= alpha; o1[r] *= alpha; }
            bf16x8 pf[2][2];
#pragma unroll
            for (int sp = 0; sp < 2; ++sp) {
                u32x4 a, c; a.x = pk2(s0[8 * sp], s0[8 * sp + 1]); a.y = pk2(s0[8 * sp + 2], s0[8 * sp + 3]); a.z = pk2(s0[8 * sp + 4], s0[8 * sp + 5]); a.w = pk2(s0[8 * sp + 6], s0[8 * sp + 7]);
                c.x = pk2(s1[8 * sp], s1[8 * sp + 1]); c.y = pk2(s1[8 * sp + 2], s1[8 * sp + 3]); c.z = pk2(s1[8 * sp + 4], s1[8 * sp + 5]); c.w = pk2(s1[8 * sp + 6], s1[8 * sp + 7]);
                pf[0][sp] = __builtin_bit_cast(bf16x8, a); pf[1][sp] = __builtin_bit_cast(bf16x8, c); }
            const LAS unsigned char* vb = lds + AT_VB + buf * 9216;
#pragma unroll
            for (int u = 0; u < 2; ++u)
#pragma unroll
                for (int sp = 0; sp < 2; ++sp) {
                    const int ko = (32 * u + 16 * sp + 4 * hi) * 2;
                    const u32x2 a0 = *(const LAS u32x2*)(vb + r32 * 144 + ko), a1 = *(const LAS u32x2*)(vb + r32 * 144 + ko + 16);
                    const u32x2 b0 = *(const LAS u32x2*)(vb + (32 + r32) * 144 + ko), b1 = *(const LAS u32x2*)(vb + (32 + r32) * 144 + ko + 16);
                    const u32x4 va = {a0.x, a0.y, a1.x, a1.y}, vb4 = {b0.x, b0.y, b1.x, b1.y};
                    o0 = __builtin_amdgcn_mfma_f32_32x32x16_bf16(__builtin_bit_cast(bf16x8, va), pf[u][sp], o0, 0, 0, 0);
                    o1 = __builtin_amdgcn_mfma_f32_32x32x16_bf16(__builtin_bit_cast(bf16x8, vb4), pf[u][sp], o1, 0, 0, 0); }
        }
        if (t + 1 < nt) lwrite(buf ^ 1);
        __syncthreads();
    }
    l_run += __shfl_xor(l_run, 32);
    const float inv = 1.0f / l_run;
    bf16_t* yp = Y + (tok0 + 32 * wid + r32) * DM + (MODE ? 0 : 768) + h * 64;
#pragma unroll
    for (int g = 0; g < 4; ++g) { u32x2 w0, w1; w0.x = pk2(o0[4 * g] * inv, o0[4 * g + 1] * inv); w0.y = pk2(o0[4 * g + 2] * inv, o0[4 * g + 3] * inv);
        w1.x = pk2(o1[4 * g] * inv, o1[4 * g + 1] * inv); w1.y = pk2(o1[4 * g + 2] * inv, o1[4 * g + 3] * inv);
        *(u32x2*)(yp + 8 * g + 4 * hi) = w0; *(u32x2*)(yp + 32 + 8 * g + 4 * hi) = w1; }
}

__device__ __forceinline__ void attention_phase(const Frame& F) {
    LAS int* uslot = (LAS int*)(F.lds + AT_UNIT);
    for (;;) {
        if (F.tid == 0) uslot[0] = (int)atomicAdd(F.ctl() + 32, 1u);
        __syncthreads();
        const int u = uslot[0];
        __syncthreads();
        if (u >= 640) break;
        if (u < 384) { const int qb = 7 - u / 48, bh = u % 48; attn_unit<1>(F, bh / 6, bh % 6, qb); }
        else { const int m = u - 384; attn_unit<0>(F, m >> 5, (m >> 3) & 3, m & 7); }
    }
}
constexpr int RS = 144;
constexpr int L_AT = 0, L_BT = 9216, L_KT = 18432, L_RT = 27648, L_BTT = 36864, L_CUM = 49152, L_AAK = 49152, L_ARB = 58368, L_TOT = 65536, L_KTT = 67584, L_VT = 76800,
              L_RHS = 86016, L_AABS = 118784, L_ARK = 135168, L_WAT = 86016, L_UVT = 95232, L_GC = 46080;
constexpr int L_LW = 0, L_LA = 16384, L_LG = 32768;
constexpr int RWU_MC = 0, RWU_QC = 8192, RWU_G1 = 16384, RWU_VB = 24576, RWU_NC = 32768, RWU_OL = 49152, RWU_BYTES = 65536;

__device__ __forceinline__ void mm_tile(f32x16& acc, const LAS unsigned char* Ab, int arow0, const LAS unsigned char* Bb, int brow0, int r32, int hi) {
#pragma unroll
    for (int s = 0; s < 4; ++s) { const bf16x8 a = *(const LAS bf16x8*)(Ab + (arow0 + r32) * RS + (16 * s + 8 * hi) * 2), b = *(const LAS bf16x8*)(Bb + (brow0 + r32) * RS + (16 * s + 8 * hi) * 2);
        acc = __builtin_amdgcn_mfma_f32_32x32x16_bf16(a, b, acc, 0, 0, 0); }
}
__device__ __forceinline__ float fast_tanh(float x) { const float e = __expf(2.0f * x); return 1.0f - 2.0f * __builtin_amdgcn_rcpf(e + 1.0f); }
__device__ __forceinline__ float fast_sigmoid(float x) { return __builtin_amdgcn_rcpf(1.0f + __expf(-x)); }
__device__ __forceinline__ void unpack8(const u32x4 w, float (&f)[8]) { f[0] = bflo(w.x); f[1] = bfhi(w.x); f[2] = bflo(w.y); f[3] = bfhi(w.y); f[4] = bflo(w.z); f[5] = bfhi(w.z); f[6] = bflo(w.w); f[7] = bfhi(w.w); }
__device__ __forceinline__ u32x4 pack8(const float (&f)[8]) { u32x4 w; w.x = pk2(f[0], f[1]); w.y = pk2(f[2], f[3]); w.z = pk2(f[4], f[5]); w.w = pk2(f[6], f[7]); return w; }

__device__ __forceinline__ void shifted8(const bf16_t* P, const float* mu, size_t tok, bool first, int col, float (&o)[8]) {
    float c[8], p[8]; unpack8(*(const u32x4*)(P + tok * INC + C_RW + col), c);
    if (!first) unpack8(*(const u32x4*)(P + (tok - 1) * INC + C_RW + col), p); else {
#pragma unroll
        for (int e = 0; e < 8; ++e) p[e] = 0.f; }
    const f32x4 m0 = *(const f32x4*)(mu + col), m1 = *(const f32x4*)(mu + col + 4);
#pragma unroll
    for (int e = 0; e < 8; ++e) o[e] = c[e] + (p[e] - c[e]) * (e < 4 ? m0[e] : m1[e - 4]);
}

template <int QS> __device__ __forceinline__ float quad_bcast(float v) {
    return __builtin_bit_cast(float, __builtin_amdgcn_mov_dpp(__builtin_bit_cast(int, v), QS * 0x55, 0xf, 0xf, true));
}
template <int S> struct SolveStep {
    static __device__ __forceinline__ void run(float (&acc)[16], const LAS float* Aq  ) {
        constexpr int ms = S >> 2;
        const float xs = quad_bcast<S & 3>(acc[ms]);
        const LAS float* row = Aq + S * 64;
#pragma unroll
        for (int m4 = ms >> 2; m4 < 4; ++m4) { const f32x4 a = *(const LAS f32x4*)(row + 4 * m4);
#pragma unroll
            for (int e = 0; e < 4; ++e) if (4 * m4 + e >= ms) acc[4 * m4 + e] += a[e] * xs; }
        SolveStep<S + 1>::run(acc, Aq);
    }
};
template <> struct SolveStep<64> { static __device__ __forceinline__ void run(float (&)[16], const LAS float*) {} };

__device__ __forceinline__ void rwkv_chunk_unit(const Frame& F, int b, int h, int c) {
    int tid = F.tid; asm volatile("" : "+v"(tid));
    const int lane = tid & 63, w = F.wave; int r32 = lane & 31, hi = lane >> 5;
    LAS unsigned char* lds = F.lds;
    const bf16_t* P = (const bf16_t*)(F.ws + WS_P); const float* mu = F.in[I_MU];
    const size_t T0 = (size_t)b * SEQ + (size_t)c * 64;
    unsigned char* ug = F.ws + WS_RW + (size_t)((b * 6 + h) * 32 + c) * RWU_BYTES;
    {
        const bf16_t* WU = (const bf16_t*)(F.ws + WS_LORA); const bf16_t* AU = WU + 384 * 64; const bf16_t* GU = WU + 2 * 384 * 64;
        const int rt = (w & 3) >> 1, ct = w & 1;
        const size_t tok = T0 + 32 * rt + r32; const bool first = (c == 0 && rt == 0 && r32 == 0);
        const int jrow = h * 64 + 32 * ct + r32;
        if (w < 4) {
            f32x16 aw = {}, aa = {};
#pragma unroll
            for (int s = 0; s < 4; ++s) { float xw[8], xa[8]; shifted8(P, mu, tok, first, RW_XW + 16 * s + 8 * hi, xw); shifted8(P, mu, tok, first, RW_XA + 16 * s + 8 * hi, xa);
#pragma unroll
                for (int e = 0; e < 8; ++e) xw[e] = fast_tanh(xw[e]);
                const bf16x8 fw = __builtin_bit_cast(bf16x8, pack8(xw)), fa = __builtin_bit_cast(bf16x8, pack8(xa));
                const bf16x8 bw = *(const bf16x8*)(WU + (size_t)jrow * 64 + 16 * s + 8 * hi), ba = *(const bf16x8*)(AU + (size_t)jrow * 64 + 16 * s + 8 * hi);
                aw = __builtin_amdgcn_mfma_f32_32x32x16_bf16(fw, bw, aw, 0, 0, 0); aa = __builtin_amdgcn_mfma_f32_32x32x16_bf16(fa, ba, aa, 0, 0, 0); }
#pragma unroll
            for (int r = 0; r < 16; ++r) { const int o = (32 * rt + crow(r, hi)) * 64 + 32 * ct + r32; ((LAS float*)(lds + L_LW))[o] = aw[r]; ((LAS float*)(lds + L_LA))[o] = aa[r]; }
        } else {
            f32x16 ag = {};
#pragma unroll
            for (int s = 0; s < 8; ++s) { float xg[8]; shifted8(P, mu, tok, first, RW_XG + 16 * s + 8 * hi, xg);
#pragma unroll
                for (int e = 0; e < 8; ++e) xg[e] = fast_sigmoid(xg[e]);
                const bf16x8 fg = __builtin_bit_cast(bf16x8, pack8(xg)); const bf16x8 bg = *(const bf16x8*)(GU + (size_t)jrow * 128 + 16 * s + 8 * hi);
                ag = __builtin_amdgcn_mfma_f32_32x32x16_bf16(fg, bg, ag, 0, 0, 0); }
#pragma unroll
            for (int r = 0; r < 16; ++r) ((LAS float*)(lds + L_LG))[(32 * rt + crow(r, hi)) * 64 + 32 * ct + r32] = ag[r];
        }
    }
    __syncthreads();
    const int t = tid >> 3, j0 = (tid & 7) * 8, hj = h * 64 + j0;
    float rr[8], km[8], vv[8], av[8], bv[8], lw[8], gg[8], bonus;
    {
        const size_t tok = T0 + t; const bool first = (c == 0 && t == 0);
        float kx[8];
        shifted8(P, mu, tok, first, RW_R + hj, rr); shifted8(P, mu, tok, first, RW_K + hj, kx); shifted8(P, mu, tok, first, RW_V + hj, vv);
        const float* w0 = F.in[I_W0] + hj; const float* a0 = F.in[I_A0] + hj; const float* kkp = F.in[I_KK] + hj; const float* kap = F.in[I_KA] + hj; const float* rkp = F.in[I_RK] + hj;
        float asg[8], kk[8], ss = 0.f, bs = 0.f;
#pragma unroll
        for (int e = 0; e < 8; ++e) {
            const float z = -(w0[e] + ((const LAS float*)(lds + L_LW))[t * 64 + j0 + e]);
            const float sp = fmaxf(z, 0.f) + log1pf(__expf(-fabsf(z)));
            lw[e] = -__expf(-sp - 0.5f);
            asg[e] = fast_sigmoid(a0[e] + ((const LAS float*)(lds + L_LA))[t * 64 + j0 + e]);
            gg[e] = ((const LAS float*)(lds + L_LG))[t * 64 + j0 + e];
            kk[e] = kx[e] * kkp[e]; ss += kk[e] * kk[e];
            km[e] = kx[e] * (1.0f + (asg[e] - 1.0f) * kap[e]);
            bs += rr[e] * km[e] * rkp[e];
        }
        ss += __shfl_xor(ss, 1); ss += __shfl_xor(ss, 2); ss += __shfl_xor(ss, 4);
        bs += __shfl_xor(bs, 1); bs += __shfl_xor(bs, 2); bs += __shfl_xor(bs, 4);
        bonus = bs;
        const float inv = 1.0f / fmaxf(sqrtf(ss), 1e-12f);
#pragma unroll
        for (int e = 0; e < 8; ++e) { const float kn = kk[e] * inv; av[e] = -kn; bv[e] = kn * asg[e]; }
    }
    __syncthreads();
    { LAS float* cum = (LAS float*)(lds + L_CUM) + t * 64 + j0; *(LAS f32x4*)cum = (f32x4){lw[0], lw[1], lw[2], lw[3]}; *(LAS f32x4*)(cum + 4) = (f32x4){lw[4], lw[5], lw[6], lw[7]}; }
    __syncthreads();
    {
        const int jc = tid & 63, seg = tid >> 6; LAS float* cum = (LAS float*)(lds + L_CUM); LAS float* tot = (LAS float*)(lds + L_TOT);
        float pre[8]; float s = 0.f;
#pragma unroll
        for (int u = 0; u < 8; ++u) { s += cum[(8 * seg + u) * 64 + jc]; pre[u] = s; }
        tot[seg * 64 + jc] = s;
        __syncthreads();
        float off = 0.f;
#pragma unroll
        for (int q = 0; q < 8; ++q) if (q < seg) off += tot[q * 64 + jc];
#pragma unroll
        for (int u = 0; u < 8; ++u) cum[(8 * seg + u) * 64 + jc] = off + pre[u];
    }
    __syncthreads();
    {
        float Li[8]; { const LAS float* cum = (const LAS float*)(lds + L_CUM) + t * 64 + j0; const f32x4 a = *(const LAS f32x4*)cum, b2 = *(const LAS f32x4*)(cum + 4);
            Li[0] = a[0]; Li[1] = a[1]; Li[2] = a[2]; Li[3] = a[3]; Li[4] = b2[0]; Li[5] = b2[1]; Li[6] = b2[2]; Li[7] = b2[3]; }
        float At[8], Bt[8], Kt[8], Rt[8];
#pragma unroll
        for (int e = 0; e < 8; ++e) { const float gi = __expf(-Li[e]); At[e] = av[e] * __expf(Li[e] - lw[e]); Bt[e] = bv[e] * gi; Kt[e] = km[e] * gi; Rt[e] = rr[e] * __expf(Li[e]); }
        if (t == 63) {
#pragma unroll
            for (int e = 0; e < 8; ++e) ((LAS float*)(lds + L_GC))[j0 + e] = __expf(Li[e]); }
        __syncthreads();
        *(LAS u32x4*)(lds + L_AT + t * RS + j0 * 2) = pack8(At); *(LAS u32x4*)(lds + L_BT + t * RS + j0 * 2) = pack8(Bt);
        *(LAS u32x4*)(lds + L_KT + t * RS + j0 * 2) = pack8(Kt); *(LAS u32x4*)(lds + L_RT + t * RS + j0 * 2) = pack8(Rt);
#pragma unroll
        for (int e = 0; e < 8; ++e) { *(LAS unsigned short*)(lds + L_BTT + (j0 + e) * RS + 2 * t) = (unsigned short)f2bf(Bt[e]); *(LAS unsigned short*)(lds + L_KTT + (j0 + e) * RS + 2 * t) = (unsigned short)f2bf(Kt[e]);
            *(LAS unsigned short*)(lds + L_VT + (j0 + e) * RS + 2 * t) = (unsigned short)f2bf(vv[e]); }
        { LAS float* rhs = (LAS float*)(lds + L_RHS) + t * 128 + j0; *(LAS f32x4*)rhs = (f32x4){At[0], At[1], At[2], At[3]}; *(LAS f32x4*)(rhs + 4) = (f32x4){At[4], At[5], At[6], At[7]}; }
        const float* gng = F.in[I_GNG] + hj; const float* gnb = F.in[I_GNB] + hj;
        float g1[8], vb[8];
#pragma unroll
        for (int e = 0; e < 8; ++e) { g1[e] = gng[e] * gg[e]; vb[e] = (gnb[e] + bonus * vv[e]) * gg[e]; }
        const int it = j0 >> 5, tt = t >> 5, rb = 4 * ((j0 >> 3) & 3);
        bf16_t* g1p = (bf16_t*)(ug + RWU_G1) + ((size_t)((it * 2 + tt) * 64 + (t & 31)) * 16 + rb); bf16_t* vbp = (bf16_t*)(ug + RWU_VB) + ((size_t)((it * 2 + tt) * 64 + (t & 31)) * 16 + rb);
        { u32x2 x; x.x = pk2(g1[0], g1[1]); x.y = pk2(g1[2], g1[3]); *(u32x2*)g1p = x; x.x = pk2(g1[4], g1[5]); x.y = pk2(g1[6], g1[7]); *(u32x2*)(g1p + 32 * 16) = x; }
        { u32x2 x; x.x = pk2(vb[0], vb[1]); x.y = pk2(vb[2], vb[3]); *(u32x2*)vbp = x; x.x = pk2(vb[4], vb[5]); x.y = pk2(vb[6], vb[7]); *(u32x2*)(vbp + 32 * 16) = x; }
    }
    __syncthreads();
    asm volatile("" : "+v"(r32), "+v"(hi));
    {
        const int p = w >> 1, ct = w & 1; const LAS unsigned char* Ab = lds + ((p & 1) ? L_KT : L_BT); const LAS unsigned char* Bb = lds + ((p >> 1) ? L_RT : L_AT);
#pragma unroll
        for (int rs_ = 0; rs_ < 2; ++rs_) { f32x16 d = {}; mm_tile(d, Ab, 32 * rs_, Bb, 32 * ct, r32, hi);
            const int tq = 32 * ct + r32;
#pragma unroll
            for (int r = 0; r < 16; ++r) { const int s = 32 * rs_ + crow(r, hi); const bool keep = (p >> 1) ? (s <= tq) : (s < tq); d[r] = keep ? d[r] : 0.f; }
            if (p == 0) {
#pragma unroll
                for (int r = 0; r < 16; ++r) { const int s = 32 * rs_ + crow(r, hi); ((LAS float*)(lds + L_AABS))[(s * 4 + (tq & 3)) * 16 + (tq >> 2)] = d[r]; }
            } else { LAS unsigned char* dst = lds + (p == 1 ? L_AAK : p == 2 ? L_ARB : L_ARK) + tq * RS;
#pragma unroll
                for (int g = 0; g < 4; ++g) { u32x2 x; x.x = pk2(d[4 * g], d[4 * g + 1]); x.y = pk2(d[4 * g + 2], d[4 * g + 3]); *(LAS u32x2*)(dst + (32 * rs_ + 8 * g + 4 * hi) * 2) = x; } }
        }
    }
    __syncthreads();
    asm volatile("" : "+v"(r32), "+v"(hi));
    if (w < 4) {
        const int rt = w >> 1, ct = w & 1; f32x16 d = {}; mm_tile(d, lds + L_AAK, 32 * rt, lds + L_VT, 32 * ct, r32, hi);
#pragma unroll
        for (int r = 0; r < 16; ++r) ((LAS float*)(lds + L_RHS))[(32 * rt + crow(r, hi)) * 128 + 64 + 32 * ct + r32] = d[r];
    }
    __syncthreads();
    {
        int l2 = lane; asm volatile("" : "+v"(l2)); const int col = 16 * w + (l2 >> 2), q = l2 & 3; float acc[16];
#pragma unroll
        for (int m = 0; m < 16; ++m) acc[m] = ((const LAS float*)(lds + L_RHS))[(4 * m + q) * 128 + col];
        __syncthreads();
        SolveStep<0>::run(acc, (const LAS float*)(lds + L_AABS) + q * 16);
        LAS unsigned char* dst = lds + (col < 64 ? L_WAT + col * RS : L_UVT + (col - 64) * RS);
#pragma unroll
        for (int m = 0; m < 16; ++m) *(LAS unsigned short*)(dst + (4 * m + q) * 2) = (unsigned short)f2bf(acc[m]);
    }
    __syncthreads();
    asm volatile("" : "+v"(r32), "+v"(hi));
    {
        const int ta = (w & 3) >> 1, tb = w & 1; const int tile = ta * 2 + tb;
        const LAS float* gc = (const LAS float*)(lds + L_GC);
        if (w < 4) {
            f32x16 d = {}; mm_tile(d, lds + L_WAT, 32 * ta, lds + L_BTT, 32 * tb, r32, hi);
            const float gcl = gc[32 * tb + r32]; float f[16];
#pragma unroll
            for (int r = 0; r < 16; ++r) f[r] = (d[r] + ((32 * ta + crow(r, hi)) == (32 * tb + r32) ? 1.0f : 0.f)) * gcl;
            u32x4 x0, x1; x0.x = pk2(f[0], f[1]); x0.y = pk2(f[2], f[3]); x0.z = pk2(f[4], f[5]); x0.w = pk2(f[6], f[7]); x1.x = pk2(f[8], f[9]); x1.y = pk2(f[10], f[11]); x1.z = pk2(f[12], f[13]); x1.w = pk2(f[14], f[15]);
            u32x4* o = (u32x4*)(ug + RWU_MC + (size_t)(tile * 64 + lane) * 32); o[0] = x0; o[1] = x1;
            f32x16 n = {}; mm_tile(n, lds + L_BTT, 32 * ta, lds + L_UVT, 32 * tb, r32, hi); mm_tile(n, lds + L_KTT, 32 * ta, lds + L_VT, 32 * tb, r32, hi);
            f32x4* on = (f32x4*)(ug + RWU_NC + (size_t)(tile * 64 + lane) * 64);
#pragma unroll
            for (int g = 0; g < 4; ++g) { f32x4 x;
#pragma unroll
                for (int e = 0; e < 4; ++e) x[e] = n[4 * g + e] * gc[32 * ta + crow(4 * g + e, hi)];
                on[g] = x; }
        } else {
            f32x16 d = {}; mm_tile(d, lds + L_WAT, 32 * ta, lds + L_ARB, 32 * tb, r32, hi);
            float f[16];
#pragma unroll
            for (int g = 0; g < 4; ++g) { const u32x2 rv = *(const LAS u32x2*)(lds + L_RT + (32 * tb + r32) * RS + (32 * ta + 8 * g + 4 * hi) * 2);
                f[4 * g] = d[4 * g] + bflo(rv.x); f[4 * g + 1] = d[4 * g + 1] + bfhi(rv.x); f[4 * g + 2] = d[4 * g + 2] + bflo(rv.y); f[4 * g + 3] = d[4 * g + 3] + bfhi(rv.y); }
            u32x4 x0, x1; x0.x = pk2(f[0], f[1]); x0.y = pk2(f[2], f[3]); x0.z = pk2(f[4], f[5]); x0.w = pk2(f[6], f[7]); x1.x = pk2(f[8], f[9]); x1.y = pk2(f[10], f[11]); x1.z = pk2(f[12], f[13]); x1.w = pk2(f[14], f[15]);
            u32x4* o = (u32x4*)(ug + RWU_QC + (size_t)(tile * 64 + lane) * 32); o[0] = x0; o[1] = x1;
            f32x16 n = {}; mm_tile(n, lds + L_UVT, 32 * ta, lds + L_ARB, 32 * tb, r32, hi); mm_tile(n, lds + L_VT, 32 * ta, lds + L_ARK, 32 * tb, r32, hi);
            f32x4* on = (f32x4*)(ug + RWU_OL + (size_t)(tile * 64 + lane) * 64);
#pragma unroll
            for (int g = 0; g < 4; ++g) on[g] = (f32x4){n[4 * g], n[4 * g + 1], n[4 * g + 2], n[4 * g + 3]};
        }
    }
    __syncthreads();
}

__device__ __forceinline__ void rwkv_chunk_phase(const Frame& F) {
    for (int u = F.bid; u < NB * 6 * 32; u += F.G) { const int c = u & 31, bh = u >> 5; rwkv_chunk_unit(F, bh / 6, bh % 6, c); }
}

__device__ __forceinline__ bf16x8 acc_frag(const f32x16& a, int s) {
    u32x4 x; x.x = pk2(a[8 * s], a[8 * s + 1]); x.y = pk2(a[8 * s + 2], a[8 * s + 3]); x.z = pk2(a[8 * s + 4], a[8 * s + 5]); x.w = pk2(a[8 * s + 6], a[8 * s + 7]); return __builtin_bit_cast(bf16x8, x);
}
__device__ __forceinline__ f32x16 lds_acc(const LAS unsigned char* p) { const LAS f32x4* q = (const LAS f32x4*)p; const f32x4 a = q[0], b = q[1], c = q[2], d = q[3];
    return (f32x16){a[0], a[1], a[2], a[3], b[0], b[1], b[2], b[3], c[0], c[1], c[2], c[3], d[0], d[1], d[2], d[3]}; }

__device__ __forceinline__ void rwkv_scan(const Frame& F, int b, int h) {
    const int tid = F.tid, lane = F.lane, r32 = lane & 31, hi = lane >> 5;
    LAS unsigned char* lds = F.lds;
    const unsigned char* ug = F.ws + WS_RW + (size_t)((b * 6 + h) * 32) * RWU_BYTES;
    bf16_t* Y = (bf16_t*)(F.ws + WS_Y);
    {
        u32x4 st[8];
#pragma unroll
        for (int k = 0; k < 8; ++k) st[k] = *(const u32x4*)(ug + (size_t)(k * NTHREADS + tid) * 16);
#pragma unroll
        for (int k = 0; k < 8; ++k) *(LAS u32x4*)(lds + (k * NTHREADS + tid) * 16) = st[k];
    }
    __syncthreads();
    f32x16 H[2][2];
#pragma unroll
    for (int a = 0; a < 2; ++a)
#pragma unroll
        for (int c2 = 0; c2 < 2; ++c2) H[a][c2] = (f32x16){};
#pragma unroll 1
    for (int c = 0; c < 32; ++c) {
        if (F.wave != 0) {
            if (c + 1 < 32) {
                const unsigned char* src = ug + (size_t)(c + 1) * RWU_BYTES; LAS unsigned char* dst = lds + ((c + 1) & 1) * RWU_BYTES;
                const int t7 = tid - 64; u32x4 st[10];
#pragma unroll
                for (int k = 0; k < 10; ++k) { const int pc = k * 448 + t7; if (pc < 4096) st[k] = *(const u32x4*)(src + (size_t)pc * 16); }
#pragma unroll
                for (int k = 0; k < 10; ++k) { const int pc = k * 448 + t7; if (pc < 4096) *(LAS u32x4*)(dst + pc * 16) = st[k]; }
            }
        } else {
            const LAS unsigned char* B = lds + (c & 1) * RWU_BYTES;
            bf16x8 hb[2][2][2];
#pragma unroll
            for (int jt = 0; jt < 2; ++jt)
#pragma unroll
                for (int it = 0; it < 2; ++it)
#pragma unroll
                    for (int s = 0; s < 2; ++s) hb[jt][it][s] = acc_frag(H[jt][it], s);
#pragma unroll 1
            for (int tt = 0; tt < 2; ++tt) {
                f32x16 O[2];
#pragma unroll
                for (int it = 0; it < 2; ++it) { f32x16 a = lds_acc(B + RWU_OL + ((it * 2 + tt) * 64 + lane) * 64);
#pragma unroll
                    for (int kt = 0; kt < 2; ++kt)
#pragma unroll
                        for (int s = 0; s < 2; ++s) { const bf16x8 q = *(const LAS bf16x8*)(B + RWU_QC + ((kt * 2 + tt) * 64 + lane) * 32 + 16 * s);
                            a = __builtin_amdgcn_mfma_f32_32x32x16_bf16(hb[kt][it][s], q, a, 0, 0, 0); }
                    O[it] = a; }
                float s1 = 0.f;
#pragma unroll
                for (int r = 0; r < 16; ++r) s1 += O[0][r] + O[1][r];
                s1 += __shfl_xor(s1, 32); const float mean = s1 * (1.0f / 64.0f);
                float s2 = 0.f;
#pragma unroll
                for (int r = 0; r < 16; ++r) { const float d0 = O[0][r] - mean, d1 = O[1][r] - mean; s2 += d0 * d0 + d1 * d1; }
                s2 += __shfl_xor(s2, 32); const float rstd = rsqrtf(s2 * (1.0f / 64.0f) + 64e-5f);
                bf16_t* yp = Y + ((size_t)b * SEQ + c * 64 + 32 * tt + r32) * DM + 384 + h * 64;
#pragma unroll
                for (int it = 0; it < 2; ++it) {
                    const LAS u32x2* g1 = (const LAS u32x2*)(B + RWU_G1 + ((it * 2 + tt) * 64 + lane) * 32); const LAS u32x2* vb = (const LAS u32x2*)(B + RWU_VB + ((it * 2 + tt) * 64 + lane) * 32);
#pragma unroll
                    for (int g = 0; g < 4; ++g) { const u32x2 gw = g1[g], vw = vb[g];
                        const float y0 = (O[it][4 * g] - mean) * rstd * bflo(gw.x) + bflo(vw.x), y1 = (O[it][4 * g + 1] - mean) * rstd * bfhi(gw.x) + bfhi(vw.x);
                        const float y2 = (O[it][4 * g + 2] - mean) * rstd * bflo(gw.y) + bflo(vw.y), y3 = (O[it][4 * g + 3] - mean) * rstd * bfhi(gw.y) + bfhi(vw.y);
                        u32x2 x; x.x = pk2(y0, y1); x.y = pk2(y2, y3); *(u32x2*)(yp + 32 * it + 8 * g + 4 * hi) = x; }
                }
            }
            __builtin_amdgcn_sched_barrier(0);
#pragma unroll
            for (int rt = 0; rt < 2; ++rt)
#pragma unroll
                for (int it = 0; it < 2; ++it) { __builtin_amdgcn_sched_barrier(0); f32x16 a = lds_acc(B + RWU_NC + ((rt * 2 + it) * 64 + lane) * 64);
#pragma unroll
                    for (int kt = 0; kt < 2; ++kt)
#pragma unroll
                        for (int s = 0; s < 2; ++s) { const bf16x8 m = *(const LAS bf16x8*)(B + RWU_MC + ((kt * 2 + rt) * 64 + lane) * 32 + 16 * s);
                            a = __builtin_amdgcn_mfma_f32_32x32x16_bf16(m, hb[kt][it][s], a, 0, 0, 0); }
                    H[rt][it] = a; }
        }
        __syncthreads();
    }
}
__global__ void __launch_bounds__(NTHREADS, 2) hymba_fwd(Params prm) {
    extern __shared__ __attribute__((aligned(16))) unsigned char lds_raw[];
    cg::grid_group grid = cg::this_grid();
    Frame F; F.lds = (LAS unsigned char*)lds_raw; F.tid = threadIdx.x; F.lane = F.tid & 63; F.wave = __builtin_amdgcn_readfirstlane(F.tid >> 6); F.G = gridDim.x; F.bid = blockIdx.x;
    F.in = prm.in; F.out = prm.out; F.ws = prm.ws;
    unsigned char* ws = prm.ws;
#define RELAUNDER() do { int t_ = threadIdx.x; asm volatile("" : "+v"(t_)); F.tid = t_; F.lane = t_ & 63; } while (0)
    p0_prologue(F);
    grid.sync(); RELAUNDER();
    kmean_task(F);
    { pg8::StaticOrder S; S.init(NTOK, INC, F.G, F.bid); EpiRowScaleBf16 E{(bf16_t*)(ws + WS_P), INC, (const float*)(ws + WS_RS1)};
      pg8::gemm_phase<false>(F.lds, (const bf16_t*)(ws + WS_XB), (const bf16_t*)(ws + WS_WIN), DM, S, E); }
    { pg8::StaticOrder S; S.init(NB * NMEM, 512, F.G, F.bid); EpiRowScaleBf16 E{(bf16_t*)(ws + WS_MKV), 512, (const float*)(ws + WS_RS1 + 65536)};
      pg8::gemm_phase<false>(F.lds, (const bf16_t*)(ws + WS_MEMB), (const bf16_t*)(ws + WS_WMKV), DM, S, E); }
    grid.sync(); RELAUNDER();
    rwkv_chunk_phase(F);
    grid.sync(); RELAUNDER();
    if (F.bid < NB * 6) rwkv_scan(F, F.bid / 6, F.bid % 6);
    RELAUNDER();
    attention_phase(F);
    grid.sync(); RELAUNDER();
    { pg8::StaticOrder S; S.init(NTOK, DM, F.G, F.bid); EpiResidual E{F.in[I_X], F.out, (bf16_t*)(ws + WS_X1B)};
      pg8::gemm_phase<false>(F.lds, (const bf16_t*)(ws + WS_Y), (const bf16_t*)(ws + WS_WOUT), DM, S, E); }
    grid.sync(); RELAUNDER();
    router_phase(F);
    grid.sync(); RELAUNDER();
    { const UTab T = build_unit_table(F, 8); pg8::TableOrder S{T.meta, T.rows, T.nunits, 0};
      EpiSwiglu E{T.meta, T.rows, (const float*)(ws + WS_RS1 + 131072), F.in[I_BGU], (bf16_t*)(ws + WS_HMID)};
      pg8::gemm_phase<true>(F.lds, (const bf16_t*)(ws + WS_X1B), (const bf16_t*)(ws + WS_WGU), DM, S, E); }
    grid.sync(); RELAUNDER();
    { const UTab T = build_unit_table(F, 4); pg8::TableOrder S{T.meta, T.rows, T.nunits, 1};
      EpiDown E{T.meta, T.rows, (const float*)(ws + WS_TOPW), F.in[I_BDN], (bf16_t*)(ws + WS_YE)};
      pg8::gemm_phase<true>(F.lds, (const bf16_t*)(ws + WS_HMID), (const bf16_t*)(ws + WS_WDN), DM, S, E); }
    grid.sync(); RELAUNDER();
    final_phase(F);
}

extern "C" void kernel_launch(void* const* d_in, const int* in_sizes, int n_in, void* d_out, int out_size, void* d_ws, size_t ws_size, hipStream_t stream) {
    static int grid = 0;
    if (grid == 0) {
        if (n_in != 27 || out_size != NTOK * DM || ws_size < WS_END) { fprintf(stderr, "kernel_launch: unexpected problem (n_in %d, out %d, ws %zu)\n", n_in, out_size, ws_size); grid = -1; return; }
        int dev = 0, cus = 0, per_cu = 0;
        hipGetDevice(&dev); hipDeviceGetAttribute(&cus, hipDeviceAttributeMultiprocessorCount, dev);
        if (hipFuncSetAttribute((const void*)hymba_fwd, hipFuncAttributeMaxDynamicSharedMemorySize, LDS_BYTES) != hipSuccess) { fprintf(stderr, "kernel_launch: hipFuncSetAttribute failed\n"); }
        if (hipOccupancyMaxActiveBlocksPerMultiprocessor(&per_cu, (const void*)hymba_fwd, NTHREADS, LDS_BYTES) != hipSuccess || per_cu < 1) { fprintf(stderr, "kernel_launch: occupancy query says %d\n", per_cu); per_cu = 1; }
        (void)hipGetLastError();
        grid = cus;
        fprintf(stderr, "kernel_launch: grid %d (per_cu %d)\n", grid, per_cu);
    }
    if (grid < 0) return;
    Params p{};
    for (int i = 0; i < 27; ++i) p.in[i] = (const float*)d_in[i];
    p.out = (float*)d_out; p.ws = (unsigned char*)d_ws;
    void* args[] = {&p};
    hipError_t e = hipLaunchCooperativeKernel((const void*)hymba_fwd, dim3(grid), dim3(NTHREADS), args, LDS_BYTES, stream);
    if (e != hipSuccess) fprintf(stderr, "kernel_launch: cooperative launch failed: %s (grid %d)\n", hipGetErrorString(e), grid);
}
```

```cpp
#include <hip/hip_runtime.h>
#include <hip/hip_cooperative_groups.h>
#include <cstdio>
#include <cstdint>
namespace cg = cooperative_groups;

#define LAS __attribute__((address_space(3)))
typedef unsigned short bf16_t;
typedef short bf16x8 __attribute__((ext_vector_type(8)));
typedef short s16x4 __attribute__((ext_vector_type(4)));
typedef float f32x2 __attribute__((ext_vector_type(2)));
typedef float f32x4 __attribute__((ext_vector_type(4)));
typedef float f32x16 __attribute__((ext_vector_type(16)));
typedef unsigned u32x2 __attribute__((ext_vector_type(2)));
typedef unsigned u32x4 __attribute__((ext_vector_type(4)));

constexpr int NB = 8, SEQ = 2048, DM = 1024, NTOK = NB * SEQ;
constexpr int INC = 2816;
constexpr int C_Q = 0, C_K = 384, C_V = 768, C_RW = 1152, C_MQ = 2560;
constexpr int RW_R = 0, RW_K = 384, RW_V = 768, RW_XW = 1152, RW_XA = 1216, RW_XG = 1280;
constexpr int NMEM = 256, NEXP = 32, TOPK = 4, NASSIGN = NTOK * TOPK;
constexpr int DUMMY_ROW = NASSIGN;
constexpr int NTHREADS = 512;

#ifndef MOE_FP8
#define MOE_FP8 1
#endif
constexpr int MOE_ESZ = MOE_FP8 ? 1 : 2;
#ifndef YE_FP8
#define YE_FP8 MOE_FP8
#endif
constexpr int YE_ESZ = YE_FP8 ? 1 : 2; constexpr float YE_SCALE = YE_FP8 ? 16.0f : 1.0f;
constexpr size_t MiB = 1u << 20;
constexpr size_t WS_CTL = 0;
constexpr size_t WS_WIN = 1 * MiB;
constexpr size_t WS_WOUT = 7 * MiB;
constexpr size_t WS_WMKV = 9 * MiB;
constexpr size_t WS_LORA = 10 * MiB;
constexpr size_t WS_RS1 = 11 * MiB;
constexpr size_t WS_XPART = 12 * MiB;
constexpr size_t WS_KM = 13 * MiB;
constexpr size_t WS_TOPW = 14 * MiB;
constexpr size_t WS_LIST = 15 * MiB;
constexpr size_t WS_MEMB = 17 * MiB;
constexpr size_t WS_MKV = 21 * MiB;
constexpr size_t WS_XB = 24 * MiB;
constexpr size_t WS_P = 56 * MiB;
constexpr size_t WS_Y = 144 * MiB;
constexpr size_t WS_X1B = 176 * MiB;
constexpr size_t WS_WGU = 208 * MiB;
constexpr size_t WS_WDN = 336 * MiB;
constexpr size_t WS_HMID = 400 * MiB;
constexpr size_t WS_YE = 530 * MiB;
constexpr size_t WS_RW = 660 * MiB;
constexpr size_t WS_END = 760 * MiB;

constexpr int RING_BYTES = 131072;
constexpr int XTRA_OFF = RING_BYTES;
constexpr int LDS_BYTES = 152 * 1024;

__device__ __forceinline__ unsigned f2bf(float f) { unsigned u = __builtin_bit_cast(unsigned, f); return (u + 0x7fffu + ((u >> 16) & 1u)) >> 16; }
typedef __bf16 bf16x2_hw __attribute__((ext_vector_type(2)));
__device__ __forceinline__ unsigned pk2(float lo, float hi) { const f32x2 v = {lo, hi}; return __builtin_bit_cast(unsigned, __builtin_convertvector(v, bf16x2_hw)); }
__device__ __forceinline__ unsigned pk4_fp8(float a, float b, float c, float d) { unsigned r = 0; r = __builtin_amdgcn_cvt_pk_fp8_f32(a, b, r, false); r = __builtin_amdgcn_cvt_pk_fp8_f32(c, d, r, true); return r; }
__device__ __forceinline__ float bf2f(unsigned short h) { return __builtin_bit_cast(float, (unsigned)h << 16); }
__device__ __forceinline__ float bflo(unsigned w) { return __builtin_bit_cast(float, w << 16); }
__device__ __forceinline__ float bfhi(unsigned w) { return __builtin_bit_cast(float, w & 0xffff0000u); }
__device__ __forceinline__ float wave_sum(float v) {
#pragma unroll
    for (int o = 32; o >= 1; o >>= 1) v += __shfl_xor(v, o);
    return v;
}

struct Params { const float* in[27]; float* out; unsigned char* ws; int phase_hi; int pad; };
enum { I_X = 0, I_MEM, I_WIN, I_WOUT, I_WMKV, I_GMIX, I_GMEM, I_GFFN, I_GFIN, I_RELB, I_MU, I_W0, I_WUP, I_A0, I_AUP, I_GUP, I_KK, I_KA, I_RK, I_GNG, I_GNB, I_WR, I_BR, I_WGU, I_BGU, I_WDN, I_BDN };

namespace pg8 {
constexpr int W8_SHIFT = 5;
constexpr int BM = 256, BK = 64, HALF = 128, HTB = HALF * BK * 2, NXCD = 8, WGM = 8;
__host__ __device__ __forceinline__ int lds_byte(int r, int c) { const int st = (r >> 4) * 2 + (c >> 5), rr = r & 15, cc = c & 31, ob = rr * 64 + cc * 2; return st * 1024 + (ob ^ (((ob >> 9) & 1) << 5)); }
__host__ __device__ __forceinline__ void stage_rc(int b, int& R, int& C) { const int st = b / 1024, sb = b % 1024, swz = sb ^ (((sb >> 9) & 1) << 5); R = (st >> 1) * 16 + swz / 64; C = (st & 1) * 32 + (swz % 64) / 2; }
__host__ __device__ __forceinline__ int perm32(int rho) { const int n = rho >> 4, i = rho & 15; return 8 * (i >> 2) + 4 * n + (i & 3); }

struct Unit { int pm, pn, ti; };

__device__ __forceinline__ int xcd_remap(int L, int nwg) { const int q = nwg / NXCD, r = nwg % NXCD, xcd = L % NXCD, off = L / NXCD; return (xcd < r ? xcd * (q + 1) : r * (q + 1) + (xcd - r) * q) + off; }

struct StaticOrder {
    int nM, nN, nwg, G, c;
    __device__ void init(int M, int N, int G_, int c_) { nM = M / BM; nN = N / BM; nwg = nM * nN; G = G_; c = c_; }
    __device__ bool next(int i, Unit& u) const {
        const long L = (long)i * G + c; if (L >= nwg) return false;
        const int wgid = xcd_remap((int)L, nwg);
        const int nig = WGM * nN, gid = wgid / nig, fm = gid * WGM, gsz = (nM - fm) < WGM ? (nM - fm) : WGM;
        u.pm = fm + ((wgid % nig) % gsz); u.pn = (wgid % nig) / gsz; u.ti = 0; return true;
    }
    __device__ __forceinline__ int srcrow(const Unit&, int) const { return 0; }
};

struct TableOrder {
    const LAS int* meta;
    const LAS int* rows;
    int nunits; int mode;
    __device__ bool next(int i, Unit& u) const { if (i >= nunits) return false; u.pm = 0; u.pn = __builtin_amdgcn_readfirstlane(meta[i * 4]); u.ti = i; return true; }
    __device__ __forceinline__ int srcrow(const Unit& u, int r) const { const int a = rows[u.ti * 256 + r]; return mode == 0 ? (a < 0 ? 0 : (a >> 2)) : (a < 0 ? DUMMY_ROW : a); }
};

__device__ __forceinline__ unsigned cvt_pk_bf16(float lo, float hi) { unsigned r; asm volatile("v_cvt_pk_bf16_f32 %0, %1, %2" : "=v"(r) : "v"(lo), "v"(hi)); return r; }

typedef int i32x8 __attribute__((ext_vector_type(8)));
template <bool GATHER, int ESZ, class Epi, class Sched>
__device__ __forceinline__ void gemm_phase(LAS unsigned char* lds, const void* A, const void* Bt, const int K, const Sched& S, const Epi& E) {
    int tid = threadIdx.x; asm volatile("" : "+v"(tid));
    const int wid = __builtin_amdgcn_readfirstlane(tid >> 6), lane = tid & 63, wr = wid >> 2, wc = wid & 3, fr = lane & 15, fq = lane >> 4;
    const int nt = K * ESZ / (BK * 2);
    unsigned voffB[2]; int RA[2], CA[2];
#pragma unroll
    for (int i = 0; i < 2; ++i) { int R, C; stage_rc(tid * 16 + i * 8192, R, C); const int Rb = (R & ~31) + perm32(R & 31);
        RA[i] = R; CA[i] = C; voffB[i] = (unsigned)(Rb * K * ESZ + C * 2); }
    const int kstep = BK * 2;
    const int hstep = HALF * K * ESZ;
    const int tstep = 2 * hstep;
    const __amdgpu_buffer_rsrc_t rA = __builtin_amdgcn_make_buffer_rsrc((void*)A, 0, -1, 0x00020000), rB = __builtin_amdgcn_make_buffer_rsrc((void*)Bt, 0, -1, 0x00020000);
    const unsigned ldsw = (unsigned)wid * 1024u;
    const int aoff = lds_byte(wr * 64 + fr, fq * 8), boff = lds_byte(wc * 32 + fr, fq * 8);
    unsigned vC[2][2], vN[2][2];
#define PG8_SA(b, h) (((b) * 2 + (h)) * HTB)
#define PG8_SB(b, h) ((4 + (b) * 2 + (h)) * HTB)
#define PG8_STAGE(bufoff, rsrc, soff, voff) do { _Pragma("unroll") for (int _i = 0; _i < 2; ++_i) \
        __builtin_amdgcn_raw_ptr_buffer_load_lds(rsrc, (LAS void*)(lds + (bufoff) + ldsw + _i * 8192), 16, (int)(voff)[_i], (int)(soff), 0, 0); } while (0)
#define PG8_LDA(dst, b, h) do { _Pragma("unroll") for (int m = 0; m < 4; ++m) { \
        if constexpr (ESZ == 2) { _Pragma("unroll") for (int k = 0; k < 2; ++k) dst[m][k] = *(const LAS bf16x8*)(lds + PG8_SA(b, h) + aoff + m * 2048 + k * 1024); } \
        else { const u32x4 lo_ = *(const LAS u32x4*)(lds + PG8_SA(b, h) + aoff + m * 2048), hi_ = *(const LAS u32x4*)(lds + PG8_SA(b, h) + aoff + m * 2048 + 1024); \
               dst##8[m] = (i32x8){(int)lo_.x, (int)lo_.y, (int)lo_.z, (int)lo_.w, (int)hi_.x, (int)hi_.y, (int)hi_.z, (int)hi_.w}; } } } while (0)
#define PG8_LDB(dst, b, h) do { _Pragma("unroll") for (int n = 0; n < 2; ++n) { \
        if constexpr (ESZ == 2) { _Pragma("unroll") for (int k = 0; k < 2; ++k) dst[n][k] = *(const LAS bf16x8*)(lds + PG8_SB(b, h) + boff + n * 2048 + k * 1024); } \
        else { const u32x4 lo_ = *(const LAS u32x4*)(lds + PG8_SB(b, h) + boff + n * 2048), hi_ = *(const LAS u32x4*)(lds + PG8_SB(b, h) + boff + n * 2048 + 1024); \
               dst##8[n] = (i32x8){(int)lo_.x, (int)lo_.y, (int)lo_.z, (int)lo_.w, (int)hi_.x, (int)hi_.y, (int)hi_.z, (int)hi_.w}; } } } while (0)
#define PG8_MMA(ai, bj, At, Bt_) do { __builtin_amdgcn_s_setprio(1); _Pragma("unroll") for (int m = 0; m < 4; ++m) _Pragma("unroll") for (int n = 0; n < 2; ++n) { \
        if constexpr (ESZ == 2) { _Pragma("unroll") for (int k = 0; k < 2; ++k) acc[ai][bj][m][n] = __builtin_amdgcn_mfma_f32_16x16x32_bf16(Bt_[n][k], At[m][k], acc[ai][bj][m][n], 0, 0, 0); } \
        else asm volatile("v_mfma_scale_f32_16x16x128_f8f6f4 %0, %1, %2, %0, %3, %4 op_sel_hi:[0,0,0]" : "+v"(acc[ai][bj][m][n]) : "v"(Bt_##8[n]), "v"(At##8[m]), "v"(scw_), "v"(sca_)); } \
        __builtin_amdgcn_s_setprio(0); } while (0)
#define PG8_WAIT_V(n) asm volatile("s_waitcnt vmcnt(" #n ")" ::: "memory")
#define PG8_WAIT_L(n) asm volatile("s_waitcnt lgkmcnt(" #n ")" ::: "memory")
#define PG8_BAR __builtin_amdgcn_s_barrier()
#define PG8_SCHED __builtin_amdgcn_sched_barrier(0)
#define PG8_SETV(dst, u) do { _Pragma("unroll") for (int _h = 0; _h < 2; ++_h) _Pragma("unroll") for (int _i = 0; _i < 2; ++_i) \
        dst[_h][_i] = GATHER ? (unsigned)(S.srcrow(u, _h * HALF + RA[_i]) * K * ESZ + CA[_i] * 2) : (unsigned)((_h * HALF + RA[_i]) * K * ESZ + CA[_i] * 2); } while (0)
    Unit cur, nxt; int ui = 0;
    if (!S.next(0, cur)) return;
    f32x4 acc[2][2][4][2];
#pragma unroll
    for (int a = 0; a < 2; ++a)
#pragma unroll
        for (int b = 0; b < 2; ++b)
#pragma unroll
            for (int m = 0; m < 4; ++m)
#pragma unroll
                for (int n = 0; n < 2; ++n) acc[a][b][m][n] = (f32x4){0.f, 0.f, 0.f, 0.f};
    const int scw_ = 127 - W8_SHIFT, sca_ = 127;
    bf16x8 At[4][2], B0[2][2], B1[2][2]; i32x8 At8[4], B08[2], B18[2];
    int cA = GATHER ? 0 : cur.pm * tstep, cB = cur.pn * tstep;
    PG8_SETV(vC, cur);
    if (GATHER) PG8_WAIT_L(0);
    PG8_STAGE(PG8_SB(0, 0), rB, cB, voffB); PG8_STAGE(PG8_SB(0, 1), rB, cB + hstep, voffB); PG8_STAGE(PG8_SA(0, 0), rA, cA, vC[0]); PG8_STAGE(PG8_SA(0, 1), rA, cA, vC[1]);
    if (wr == 1) PG8_BAR;
    PG8_WAIT_V(2); PG8_BAR;
    PG8_STAGE(PG8_SB(1, 0), rB, cB + kstep, voffB); PG8_STAGE(PG8_SA(1, 0), rA, cA + kstep, vC[0]); PG8_STAGE(PG8_SB(1, 1), rB, cB + hstep + kstep, voffB);
    PG8_WAIT_V(6); PG8_BAR;
    for (;;) {
        const bool has_next = S.next(ui + 1, nxt);
        float pre_[24]; E.pre(pre_, cur, wr, wc, fr, fq);
        const int nA = GATHER ? 0 : (has_next ? nxt.pm * tstep : cA), nB = has_next ? nxt.pn * tstep : cB;
        if (GATHER) { if (has_next) { PG8_SETV(vN, nxt); } else {
#pragma unroll
            for (int h = 0; h < 2; ++h)
#pragma unroll
                for (int i = 0; i < 2; ++i) vN[h][i] = vC[h][i]; } }
#pragma unroll 1
        for (int t = 0; t < nt; t += 2) {
            const bool last = (t == nt - 2);
            const int a1 = cA + (t + 1) * kstep;
            const int a2 = last ? nA : cA + (t + 2) * kstep, b2 = last ? nB : cB + (t + 2) * kstep;
            const int a3 = a2 + kstep, b3 = b2 + kstep;
            unsigned v2[2][2];
#pragma unroll
            for (int h = 0; h < 2; ++h)
#pragma unroll
                for (int i = 0; i < 2; ++i) v2[h][i] = (GATHER && last) ? vN[h][i] : vC[h][i];
            PG8_LDB(B0, 0, 0); PG8_LDB(B1, 0, 1); PG8_SCHED; PG8_LDA(At, 0, 0); PG8_STAGE(PG8_SA(1, 1), rA, a1, vC[1]);
            PG8_WAIT_V(8); PG8_WAIT_L(0); PG8_BAR; PG8_MMA(0, 0, At, B0); PG8_MMA(0, 1, At, B1); PG8_BAR; PG8_SCHED;
            PG8_LDA(At, 0, 1); PG8_STAGE(PG8_SB(0, 0), rB, b2, voffB); PG8_STAGE(PG8_SB(0, 1), rB, b2 + hstep, voffB); PG8_STAGE(PG8_SA(0, 0), rA, a2, v2[0]);
            PG8_WAIT_V(8); PG8_WAIT_L(0); PG8_BAR; PG8_MMA(1, 0, At, B0); PG8_MMA(1, 1, At, B1); PG8_BAR; PG8_SCHED;
            PG8_LDB(B0, 1, 0); PG8_LDB(B1, 1, 1); PG8_SCHED; PG8_LDA(At, 1, 0); PG8_STAGE(PG8_SA(0, 1), rA, a2, v2[1]);
            PG8_WAIT_V(8); PG8_WAIT_L(0); PG8_BAR; PG8_MMA(0, 0, At, B0); PG8_MMA(0, 1, At, B1); PG8_BAR; PG8_SCHED;
            PG8_LDA(At, 1, 1); PG8_STAGE(PG8_SB(1, 0), rB, b3, voffB); PG8_STAGE(PG8_SB(1, 1), rB, b3 + hstep, voffB); PG8_STAGE(PG8_SA(1, 0), rA, a3, v2[0]);
            PG8_WAIT_V(8); PG8_WAIT_L(0); PG8_BAR; PG8_MMA(1, 0, At, B0); PG8_MMA(1, 1, At, B1); PG8_BAR; PG8_SCHED;
        }
        if (wr == 0) PG8_BAR;
        if constexpr (ESZ == 1) asm volatile("s_nop 15\n\ts_nop 7" ::: "memory");
        { int l2_ = lane; asm volatile("" : "+v"(l2_));
          E(acc, cur, wr, wc, l2_ & 15, l2_ >> 4, pre_); }
        if (!has_next) break;
#pragma unroll
        for (int a = 0; a < 2; ++a)
#pragma unroll
            for (int b = 0; b < 2; ++b)
#pragma unroll
                for (int m = 0; m < 4; ++m)
#pragma unroll
                    for (int n = 0; n < 2; ++n) acc[a][b][m][n] = (f32x4){0.f, 0.f, 0.f, 0.f};
        cur = nxt; cA = nA; cB = nB; ++ui;
#pragma unroll
        for (int h = 0; h < 2; ++h)
#pragma unroll
            for (int i = 0; i < 2; ++i) vC[h][i] = vN[h][i];
        if (wr == 1) PG8_BAR;
    }
    PG8_WAIT_V(0);
    PG8_BAR;
#undef PG8_SA
#undef PG8_SB
#undef PG8_STAGE
#undef PG8_LDA
#undef PG8_LDB
#undef PG8_MMA
#undef PG8_WAIT_V
#undef PG8_WAIT_L
#undef PG8_BAR
#undef PG8_SCHED
#undef PG8_SETV
}
}
#define XB_TMO      128
#define XB_XCNT(j)  (256  + 64 * (j))
#define XB_XSUB(j)  (1280 + 64 * (j))
#define XB_XGEN(j)  (2304 + 64 * (j))
#define XB_TOP      3328
#define XB_TOPGEN   3392
#define XCD_BAR_WORDS 3456
#define XB_SPIN_CAP (1u << 18)
__device__ __forceinline__ unsigned xb_ld(unsigned* p)              { return __hip_atomic_load(p, __ATOMIC_RELAXED, __HIP_MEMORY_SCOPE_AGENT); }
__device__ __forceinline__ unsigned xb_add(unsigned* p, unsigned v) { return __hip_atomic_fetch_add(p, v, __ATOMIC_RELAXED, __HIP_MEMORY_SCOPE_AGENT); }
__device__ __forceinline__ unsigned xb_xcc_id() { return (unsigned)__builtin_amdgcn_s_getreg((3 << 11) | 20) & 0xFu; }
#define XB_SPIN(cond, bar) do { unsigned _sp = 0; while (cond) { __builtin_amdgcn_s_sleep(1); \
    if ((++_sp & 255u) == 0u) { if (xb_ld(&(bar)[XB_TMO])) break; if (_sp > XB_SPIN_CAP) { atomicAdd(&(bar)[XB_TMO], 1u); break; } } } } while (0)
struct XcdBarrier { unsigned* bar; unsigned x; volatile LAS unsigned* st; };
__device__ __forceinline__ XcdBarrier xcd_barrier_post(unsigned* bar, volatile LAS unsigned* st) {
    XcdBarrier b; b.bar = bar; b.x = xb_xcc_id(); b.st = st;
    if (threadIdx.x == 0) (void)xb_add(&bar[XB_XCNT(b.x)], 1u);
    return b;
}
__device__ __forceinline__ void xcd_barrier_complete(unsigned* bar, unsigned x, unsigned& nloc, unsigned& nx) {
    const unsigned G = gridDim.x * gridDim.y * gridDim.z;
    unsigned sum, cnt, mine, sp = 0u;
    for (;;) {
        sum = 0u; cnt = 0u; mine = 0u;
#pragma unroll
        for (unsigned j = 0; j < 16; ++j) { const unsigned c = xb_ld(&bar[XB_XCNT(j)]); sum += c; cnt += (c > 0u) ? 1u : 0u; mine = (j == x) ? c : mine; }
        if (sum == G) break;
        __builtin_amdgcn_s_sleep(1);
        if ((++sp & 255u) == 0u) { if (xb_ld(&bar[XB_TMO])) break; if (sp > XB_SPIN_CAP) { atomicAdd(&bar[XB_TMO], 1u); break; } }
    }
    nloc = mine > 0u ? mine : 1u; nx = cnt > 0u ? cnt : 1u;
}
__device__ __forceinline__ void xcd_barrier(const XcdBarrier& b) {
    asm volatile("s_waitcnt vmcnt(0)" ::: "memory");
    __syncthreads();
    if (threadIdx.x == 0) {
        unsigned* bar = b.bar;
        __builtin_amdgcn_s_waitcnt(0);
        unsigned nloc = b.st[0], nx = b.st[1];
        if (nloc == 0u) { xcd_barrier_complete(bar, b.x, nloc, nx); b.st[0] = nloc; b.st[1] = nx; }
        const unsigned old = xb_add(&bar[XB_XSUB(b.x)], 1u);
        const unsigned gen = old / nloc;
        if (old + 1u == (gen + 1u) * nloc) {
            __builtin_amdgcn_fence(__ATOMIC_RELEASE, "agent");
            asm volatile("s_waitcnt vmcnt(0)" ::: "memory");
            const unsigned og = xb_add(&bar[XB_TOP], 1u);
            const unsigned tg = og / nx;
            if (og + 1u == (tg + 1u) * nx) xb_add(&bar[XB_TOPGEN], 1u);
            else XB_SPIN(xb_ld(&bar[XB_TOPGEN]) == tg, bar);
            __builtin_amdgcn_fence(__ATOMIC_ACQUIRE, "agent");
            xb_add(&bar[XB_XGEN(b.x)], 1u);
            asm volatile("s_waitcnt vmcnt(0)" ::: "memory");
        } else {
            XB_SPIN(xb_ld(&bar[XB_XGEN(b.x)]) == gen, bar);
            __builtin_amdgcn_fence(__ATOMIC_ACQUIRE, "agent");
            asm volatile("s_waitcnt vmcnt(0)" ::: "memory");
        }
    }
    __syncthreads();
}
using pg8::Unit; using pg8::HALF; using pg8::BM; using pg8::cvt_pk_bf16;

struct EpiRowScaleBf16 {
    bf16_t* O; int ldc; const float* rs;
    __device__ __forceinline__ void pre(float (&p)[24], const Unit& u, int wr, int wc, int fr, int fq) const {
#pragma unroll
        for (int ai = 0; ai < 2; ++ai)
#pragma unroll
            for (int m = 0; m < 4; ++m) p[ai * 4 + m] = rs[u.pm * BM + wr * 64 + fr + ai * HALF + m * 16]; }
    __device__ __forceinline__ void operator()(const f32x4 (&acc)[2][2][4][2], const Unit& u, int wr, int wc, int fr, int fq, const float (&p)[24]) const {
        const int row0 = u.pm * BM + wr * 64 + fr, col0 = u.pn * BM + wc * 32 + 8 * fq;
#pragma unroll
        for (int ai = 0; ai < 2; ++ai)
#pragma unroll
            for (int m = 0; m < 4; ++m) { const int row = row0 + ai * HALF + m * 16; const float s = p[ai * 4 + m]; bf16_t* rowp = O + (size_t)row * ldc + col0;
#pragma unroll
                for (int bj = 0; bj < 2; ++bj) { const f32x4 v0 = acc[ai][bj][m][0] * s, v1 = acc[ai][bj][m][1] * s;
                    u32x4 w; w.x = cvt_pk_bf16(v0[0], v0[1]); w.y = cvt_pk_bf16(v0[2], v0[3]); w.z = cvt_pk_bf16(v1[0], v1[1]); w.w = cvt_pk_bf16(v1[2], v1[3]);
                    *(u32x4*)(rowp + bj * HALF) = w; } }
    }
};

struct EpiResidual {
    const float* X; float* X1; unsigned char* X1B;
    __device__ __forceinline__ void pre(float (&)[24], const Unit&, int, int, int, int) const {}
    __device__ __forceinline__ void operator()(const f32x4 (&acc)[2][2][4][2], const Unit& u, int wr, int wc, int fr, int fq, const float (&)[24]) const {
        const int row0 = u.pm * BM + wr * 64 + fr, col0 = u.pn * BM + wc * 32 + 8 * fq;
#pragma unroll
        for (int ai = 0; ai < 2; ++ai)
#pragma unroll
            for (int m = 0; m < 4; ++m) { const size_t ro = (size_t)(row0 + ai * HALF + m * 16) * DM + col0;
#pragma unroll
                for (int bj = 0; bj < 2; ++bj) { const f32x4 x0 = *(const f32x4*)(X + ro + bj * HALF), x1 = *(const f32x4*)(X + ro + bj * HALF + 4);
                    const f32x4 v0 = acc[ai][bj][m][0] + x0, v1 = acc[ai][bj][m][1] + x1;
                    *(f32x4*)(X1 + ro + bj * HALF) = v0; *(f32x4*)(X1 + ro + bj * HALF + 4) = v1;
                    if (MOE_ESZ == 2) { u32x4 w; w.x = cvt_pk_bf16(v0[0], v0[1]); w.y = cvt_pk_bf16(v0[2], v0[3]); w.z = cvt_pk_bf16(v1[0], v1[1]); w.w = cvt_pk_bf16(v1[2], v1[3]);
                        *(u32x4*)(X1B + (ro + bj * HALF) * 2) = w; }
                    else { u32x2 w; w.x = pk4_fp8(v0[0], v0[1], v0[2], v0[3]); w.y = pk4_fp8(v1[0], v1[1], v1[2], v1[3]); *(u32x2*)(X1B + ro + bj * HALF) = w; } } }
    }
};

struct EpiSwiglu {
    const LAS int* meta; const LAS int* rows; const float* rs2; const float* bgu; unsigned char* H;
    __device__ __forceinline__ void pre(float (&p)[24], const Unit& u, int wr, int wc, int fr, int fq) const {
#pragma unroll
        for (int ai = 0; ai < 2; ++ai)
#pragma unroll
            for (int m = 0; m < 4; ++m) { const int aid = rows[u.ti * 256 + ai * HALF + wr * 64 + m * 16 + fr]; p[ai * 4 + m] = rs2[aid < 0 ? 0 : (aid >> 2)]; }
        const int e = __builtin_amdgcn_readfirstlane(meta[u.ti * 4 + 1]), pnl = __builtin_amdgcn_readfirstlane(meta[u.ti * 4 + 2]);
        const float* bp = bgu + (size_t)e * 2048 + 2 * (pnl * 128 + wc * 32 + 8 * fq);
#pragma unroll
        for (int q = 0; q < 4; ++q) { const f32x4 t = *(const f32x4*)(bp + 4 * q); p[8 + 4 * q] = t[0]; p[9 + 4 * q] = t[1]; p[10 + 4 * q] = t[2]; p[11 + 4 * q] = t[3]; } }
    __device__ __forceinline__ void operator()(const f32x4 (&acc)[2][2][4][2], const Unit& u, int wr, int wc, int fr, int fq, const float (&p)[24]) const {
        const int e = __builtin_amdgcn_readfirstlane(meta[u.ti * 4 + 1]), pnl = __builtin_amdgcn_readfirstlane(meta[u.ti * 4 + 2]);
        const int j0 = pnl * 128 + wc * 32 + 8 * fq;
        const float* bp = bgu + (size_t)e * 2048 + 2 * j0;
        float bg[8], bu[8];
#pragma unroll
        for (int q = 0; q < 4; ++q) { bg[2 * q] = p[8 + 4 * q]; bu[2 * q] = p[9 + 4 * q]; bg[2 * q + 1] = p[10 + 4 * q]; bu[2 * q + 1] = p[11 + 4 * q]; }
#pragma unroll
        for (int ai = 0; ai < 2; ++ai)
#pragma unroll
            for (int m = 0; m < 4; ++m) { const int r = ai * HALF + wr * 64 + m * 16 + fr; const int aid = rows[u.ti * 256 + r];
                const float s = p[ai * 4 + m]; unsigned char* rowp = H + ((size_t)(aid < 0 ? DUMMY_ROW : aid) * DM + j0) * MOE_ESZ;
                float o[8];
#pragma unroll
                for (int n = 0; n < 2; ++n)
#pragma unroll
                    for (int q = 0; q < 4; ++q) { float g = acc[ai][0][m][n][q] * s + bg[4 * n + q], up = acc[ai][1][m][n][q] * s + bu[4 * n + q];
                        g = fminf(g, 7.0f); up = fminf(fmaxf(up, -7.0f), 7.0f);
                        const float glu = g * __builtin_amdgcn_rcpf(1.0f + __expf(-1.702f * g));
                        o[4 * n + q] = (up + 1.0f) * glu; }
                if (MOE_ESZ == 2) { u32x4 w; w.x = cvt_pk_bf16(o[0], o[1]); w.y = cvt_pk_bf16(o[2], o[3]); w.z = cvt_pk_bf16(o[4], o[5]); w.w = cvt_pk_bf16(o[6], o[7]); *(u32x4*)rowp = w; }
                else { u32x2 w; w.x = pk4_fp8(o[0], o[1], o[2], o[3]); w.y = pk4_fp8(o[4], o[5], o[6], o[7]); *(u32x2*)rowp = w; } }
    }
};

struct EpiDown {
    const LAS int* meta; const LAS int* rows; const float* topw; const float* bdn; unsigned char* Y;
    __device__ __forceinline__ void pre(float (&p)[24], const Unit& u, int wr, int wc, int fr, int fq) const {
#pragma unroll
        for (int ai = 0; ai < 2; ++ai)
#pragma unroll
            for (int m = 0; m < 4; ++m) { const int aid = rows[u.ti * 256 + ai * HALF + wr * 64 + m * 16 + fr]; p[ai * 4 + m] = topw[aid < 0 ? 0 : aid]; }
        const int e = __builtin_amdgcn_readfirstlane(meta[u.ti * 4 + 1]), pnl = __builtin_amdgcn_readfirstlane(meta[u.ti * 4 + 2]);
        const int col0 = pnl * BM + wc * 32 + 8 * fq;
#pragma unroll
        for (int bj = 0; bj < 2; ++bj)
#pragma unroll
            for (int n = 0; n < 2; ++n) { const f32x4 t = *(const f32x4*)(bdn + (size_t)e * DM + col0 + bj * HALF + 4 * n); p[8 + (bj * 2 + n) * 4] = t[0]; p[9 + (bj * 2 + n) * 4] = t[1]; p[10 + (bj * 2 + n) * 4] = t[2]; p[11 + (bj * 2 + n) * 4] = t[3]; } }
    __device__ __forceinline__ void operator()(const f32x4 (&acc)[2][2][4][2], const Unit& u, int wr, int wc, int fr, int fq, const float (&p)[24]) const {
        const int e = __builtin_amdgcn_readfirstlane(meta[u.ti * 4 + 1]), pnl = __builtin_amdgcn_readfirstlane(meta[u.ti * 4 + 2]);
        const int col0 = pnl * BM + wc * 32 + 8 * fq;
        f32x4 bv[2][2];
#pragma unroll
        for (int bj = 0; bj < 2; ++bj)
#pragma unroll
            for (int n = 0; n < 2; ++n) bv[bj][n] = (f32x4){p[8 + (bj * 2 + n) * 4], p[9 + (bj * 2 + n) * 4], p[10 + (bj * 2 + n) * 4], p[11 + (bj * 2 + n) * 4]};
#pragma unroll
        for (int ai = 0; ai < 2; ++ai)
#pragma unroll
            for (int m = 0; m < 4; ++m) { const int r = ai * HALF + wr * 64 + m * 16 + fr; const int aid = rows[u.ti * 256 + r];
                const float s = p[ai * 4 + m] * YE_SCALE; unsigned char* rowp = Y + ((size_t)(aid < 0 ? DUMMY_ROW : aid) * DM + col0) * YE_ESZ;
#pragma unroll
                for (int bj = 0; bj < 2; ++bj) { const f32x4 v0 = (acc[ai][bj][m][0] + bv[bj][0]) * s, v1 = (acc[ai][bj][m][1] + bv[bj][1]) * s;
                    if (YE_ESZ == 2) { u32x4 w; w.x = cvt_pk_bf16(v0[0], v0[1]); w.y = cvt_pk_bf16(v0[2], v0[3]); w.z = cvt_pk_bf16(v1[0], v1[1]); w.w = cvt_pk_bf16(v1[2], v1[3]);
                        *(u32x4*)(rowp + bj * HALF * 2) = w; }
                    else { u32x2 w; w.x = pk4_fp8(v0[0], v0[1], v0[2], v0[3]); w.y = pk4_fp8(v1[0], v1[1], v1[2], v1[3]); *(u32x2*)(rowp + bj * HALF) = w; } } }
    }
};

struct Frame {
    LAS unsigned char* lds; int tid, lane, wave, G, bid;
    const float* const* in; float* out; unsigned char* ws;
    __device__ __forceinline__ unsigned* ctl() const { return (unsigned*)(ws + WS_CTL); }
};

__device__ __forceinline__ void p0_rows(const Frame& F) {
    const float* x = F.in[I_X]; bf16_t* XB = (bf16_t*)(F.ws + WS_XB); float* RS1 = (float*)(F.ws + WS_RS1); float* XP = (float*)(F.ws + WS_XPART);
    LAS float* red = (LAS float*)F.lds;
    for (int g = F.bid; g < NTOK / 64; g += F.G) {
        float xs[16];
#pragma unroll
        for (int i = 0; i < 16; ++i) xs[i] = 0.f;
#pragma unroll 4
        for (int i = 0; i < 8; ++i) { const int row = g * 64 + F.wave * 8 + i; const float* xr = x + (size_t)row * DM;
            f32x4 v[4]; float ss = 0.f;
#pragma unroll
            for (int j = 0; j < 4; ++j) { v[j] = *(const f32x4*)(xr + 256 * j + 4 * F.lane); ss += v[j][0] * v[j][0] + v[j][1] * v[j][1] + v[j][2] * v[j][2] + v[j][3] * v[j][3]; }
            ss = wave_sum(ss); const float rs = rsqrtf(ss * (1.0f / DM) + 1e-5f);
            if (F.lane == 0) RS1[row] = rs;
#pragma unroll
            for (int j = 0; j < 4; ++j) { u32x2 w; w.x = pk2(v[j][0], v[j][1]); w.y = pk2(v[j][2], v[j][3]); *(u32x2*)(XB + (size_t)row * DM + 256 * j + 4 * F.lane) = w;
#pragma unroll
                for (int e = 0; e < 4; ++e) xs[4 * j + e] += rs * v[j][e]; } }
#pragma unroll
        for (int j = 0; j < 4; ++j)
#pragma unroll
            for (int e = 0; e < 4; ++e) red[F.wave * 1024 + 256 * j + 4 * F.lane + e] = xs[4 * j + e];
        __syncthreads();
        for (int c = F.tid; c < 1024; c += NTHREADS) { float s = 0.f;
#pragma unroll
            for (int w = 0; w < 8; ++w) s += red[w * 1024 + c];
            XP[(size_t)g * 1024 + c] = s; }
        __syncthreads();
    }
    const float* mem = F.in[I_MEM]; bf16_t* MB = (bf16_t*)(F.ws + WS_MEMB); float* RSM = (float*)(F.ws + WS_RS1 + 65536);
    for (int row = F.bid * 8 + F.wave; row < NB * NMEM; row += F.G * 8) { const float* xr = mem + (size_t)row * DM;
        f32x4 v[4]; float ss = 0.f;
#pragma unroll
        for (int j = 0; j < 4; ++j) { v[j] = *(const f32x4*)(xr + 256 * j + 4 * F.lane); ss += v[j][0] * v[j][0] + v[j][1] * v[j][1] + v[j][2] * v[j][2] + v[j][3] * v[j][3]; }
        ss = wave_sum(ss); if (F.lane == 0) RSM[row] = rsqrtf(ss * (1.0f / DM) + 1e-5f);
#pragma unroll
        for (int j = 0; j < 4; ++j) { u32x2 w; w.x = pk2(v[j][0], v[j][1]); w.y = pk2(v[j][2], v[j][3]); *(u32x2*)(MB + (size_t)row * DM + 256 * j + 4 * F.lane) = w; }
    }
}

struct TJob { const float* src; bf16_t* dst; const float* gk; int K, N, ntk, ntn, perm; size_t es_src, es_dst; };
__device__ __forceinline__ int tjob_destrow(const TJob& J, int n) { if (!J.perm) return n; const int j = n >> 1, up = n & 1; return (j >> 7) * 256 + up * 128 + (j & 127); }
__device__ __forceinline__ void tjob_load(const TJob& J, int t, int tid, f32x4 (&v)[4], f32x4& g) {
    const int per = J.ntk * J.ntn, e = t / per, tile = t % per;
    const int tk = tile % J.ntk, tn = tile / J.ntk; const int r = tid >> 5, c4 = (tid & 31) * 4;
    const float* src = J.src + (size_t)e * J.es_src;
#pragma unroll
    for (int p = 0; p < 4; ++p) { const int k = tk * 64 + p * 16 + r; v[p] = *(const f32x4*)(src + (size_t)k * J.N + tn * 128 + c4); g[p] = J.gk ? J.gk[k] : 1.0f; }
}
__device__ __forceinline__ void tjob_store(const TJob& J, int t, int tid, const f32x4 (&v)[4], const f32x4& gs, LAS float* T  ) {
    const int per = J.ntk * J.ntn, e = t / per, tile = t % per;
    const int tk = tile % J.ntk, tn = tile / J.ntk; const int r = tid >> 5, c = tid & 31, rot = c >> 3;
#pragma unroll
    for (int p = 0; p < 4; ++p) { const float g = gs[p];
#pragma unroll
        for (int q = 0; q < 4; ++q) { const int ee = (q + rot) & 3;
            const float x = ee == 0 ? v[p][0] : ee == 1 ? v[p][1] : ee == 2 ? v[p][2] : v[p][3];
            T[(4 * c + ee) * 65 + p * 16 + r] = x * g; } }
    __syncthreads();
    const int n = tid >> 2, ks = (tid & 3) * 16;
    float f[16];
#pragma unroll
    for (int i = 0; i < 16; ++i) f[i] = T[n * 65 + ks + i];
    u32x4 w0, w1; w0.x = pk2(f[0], f[1]); w0.y = pk2(f[2], f[3]); w0.z = pk2(f[4], f[5]); w0.w = pk2(f[6], f[7]); w1.x = pk2(f[8], f[9]); w1.y = pk2(f[10], f[11]); w1.z = pk2(f[12], f[13]); w1.w = pk2(f[14], f[15]);
    bf16_t* d = J.dst + (size_t)e * J.es_dst + (size_t)tjob_destrow(J, tn * 128 + n) * J.K + tk * 64 + ks;
    *(u32x4*)d = w0; *(u32x4*)(d + 8) = w1;
    __syncthreads();
}
__device__ __forceinline__ void run_tjob(const Frame& F, const TJob& J, int nexp) {
    const int total = J.ntk * J.ntn * nexp, G = F.G;
    LAS float* T = (LAS float*)F.lds;
    f32x4 va[4], vb[4], vc[4], ga, gb, gc;
    const int t0 = F.bid;
    if (t0 < total) tjob_load(J, t0, F.tid, va, ga);
    if (t0 + G < total) tjob_load(J, t0 + G, F.tid, vb, gb);
    if (t0 + 2 * G < total) tjob_load(J, t0 + 2 * G, F.tid, vc, gc);
    for (int t = t0; t < total; t += 3 * G) {
        tjob_store(J, t, F.tid, va, ga, T); if (t + 3 * G < total) tjob_load(J, t + 3 * G, F.tid, va, ga);
        if (t + G < total) { tjob_store(J, t + G, F.tid, vb, gb, T); if (t + 4 * G < total) tjob_load(J, t + 4 * G, F.tid, vb, gb); }
        if (t + 2 * G < total) { tjob_store(J, t + 2 * G, F.tid, vc, gc, T); if (t + 5 * G < total) tjob_load(J, t + 5 * G, F.tid, vc, gc); }
    }
}

__device__ __forceinline__ void p0_prologue(const Frame& F) {
    if (F.bid == 0 && F.tid < 64) F.ctl()[F.tid] = 0u;
    p0_rows(F);
    const float* const* in = F.in;
    { TJob J{in[I_WIN], (bf16_t*)(F.ws + WS_WIN), in[I_GMIX], 1024, INC, 16, INC / 128, 0, 0, 0}; run_tjob(F, J, 1); }
    { TJob J{in[I_WOUT], (bf16_t*)(F.ws + WS_WOUT), nullptr, 1024, 1024, 16, 8, 0, 0, 0}; run_tjob(F, J, 1); }
    { TJob J{in[I_WMKV], (bf16_t*)(F.ws + WS_WMKV), in[I_GMEM], 1024, 512, 16, 4, 0, 0, 0}; run_tjob(F, J, 1); }
    { TJob J{in[I_WUP], (bf16_t*)(F.ws + WS_LORA), nullptr, 64, 384, 1, 3, 0, 0, 0}; run_tjob(F, J, 1); }
    { TJob J{in[I_AUP], (bf16_t*)(F.ws + WS_LORA) + 384 * 64, nullptr, 64, 384, 1, 3, 0, 0, 0}; run_tjob(F, J, 1); }
    { TJob J{in[I_GUP], (bf16_t*)(F.ws + WS_LORA) + 2 * 384 * 64, nullptr, 128, 384, 2, 3, 0, 0, 0}; run_tjob(F, J, 1); }
}
constexpr int MOE_T1 = 16 * 16 * NEXP, MOE_T2 = 16 * 8 * NEXP, MOE_TT = MOE_T1 + MOE_T2;
struct MoeTile { const float* src; unsigned char* dst; int N, gate, tk, tn; };
__device__ __forceinline__ MoeTile moe_tile(const float* wgu, const float* wdn, unsigned char* dgu, unsigned char* ddn, int t) {
    const bool first = t < MOE_T1; const int tt = first ? t : t - MOE_T1; const int per = first ? 256 : 128, e = first ? (tt >> 8) : (tt >> 7), tile = tt & (per - 1);
    MoeTile m; m.N = first ? 2048 : 1024; m.gate = first ? 1 : 0; m.tk = tile & 15; m.tn = tile >> 4;
    m.src = first ? wgu + (size_t)e * 1024 * 2048 : wdn + (size_t)e * 1024 * 1024; m.dst = first ? dgu + (size_t)e * 2048 * 1024 * MOE_ESZ : ddn + (size_t)e * 1024 * 1024 * MOE_ESZ; return m;
}
__device__ __forceinline__ void moe_tile_load(const MoeTile& m, int tid, f32x4 (&v)[4]) {
    const int r = tid >> 5, c4 = (tid & 31) * 4;
#pragma unroll
    for (int p = 0; p < 4; ++p) v[p] = *(const f32x4*)(m.src + (size_t)(m.tk * 64 + (MOE_ESZ == 1 ? 4 * r + p : p * 16 + r)) * m.N + m.tn * 128 + c4);
}
__device__ __forceinline__ void moe_tile_store(const MoeTile& m, int tid, const f32x4 (&v)[4], LAS float* T, const LAS float* GT) {
    const int r = tid >> 5, c = tid & 31, rot = c >> 3;
    const int n = tid >> 2;
    const int nn = m.tn * 128 + n, j = nn >> 1; const int drow = m.gate ? ((j >> 7) * 256 + (nn & 1) * 128 + (j & 127)) : nn;
    if (MOE_ESZ == 1) {
        LAS unsigned* T2 = (LAS unsigned*)T;
        float g[4];
#pragma unroll
        for (int p = 0; p < 4; ++p) g[p] = (m.gate ? GT[m.tk * 64 + 4 * r + p] : 1.0f) * (float)(1 << pg8::W8_SHIFT);
#pragma unroll
        for (int q = 0; q < 4; ++q) { const int ee = (q + rot) & 3;
            const float x0 = ee == 0 ? v[0][0] : ee == 1 ? v[0][1] : ee == 2 ? v[0][2] : v[0][3], x1 = ee == 0 ? v[1][0] : ee == 1 ? v[1][1] : ee == 2 ? v[1][2] : v[1][3];
            const float x2 = ee == 0 ? v[2][0] : ee == 1 ? v[2][1] : ee == 2 ? v[2][2] : v[2][3], x3 = ee == 0 ? v[3][0] : ee == 1 ? v[3][1] : ee == 2 ? v[3][2] : v[3][3];
            T2[(4 * c + ee) * 17 + r] = pk4_fp8(x0 * g[0], x1 * g[1], x2 * g[2], x3 * g[3]); }
        __syncthreads();
        const int qd = (tid & 3) * 4;
        u32x4 w; w.x = T2[n * 17 + qd]; w.y = T2[n * 17 + qd + 1]; w.z = T2[n * 17 + qd + 2]; w.w = T2[n * 17 + qd + 3];
        *(u32x4*)(m.dst + (size_t)drow * 1024 + m.tk * 64 + 4 * qd) = w;
        __syncthreads();
    } else {
#pragma unroll
        for (int p = 0; p < 4; ++p) { const float gk = GT[m.tk * 64 + p * 16 + r]; const float g = m.gate ? gk : 1.0f;
#pragma unroll
            for (int q = 0; q < 4; ++q) { const int ee = (q + rot) & 3;
                const float x = ee == 0 ? v[p][0] : ee == 1 ? v[p][1] : ee == 2 ? v[p][2] : v[p][3];
                T[(4 * c + ee) * 65 + p * 16 + r] = x * g; } }
        __syncthreads();
        const int ks = (tid & 3) * 16;
        float f[16];
#pragma unroll
        for (int i = 0; i < 16; ++i) f[i] = T[n * 65 + ks + i];
        unsigned char* d = m.dst + ((size_t)drow * 1024 + m.tk * 64 + ks) * 2;
        u32x4 w0, w1; w0.x = pk2(f[0], f[1]); w0.y = pk2(f[2], f[3]); w0.z = pk2(f[4], f[5]); w0.w = pk2(f[6], f[7]); w1.x = pk2(f[8], f[9]); w1.y = pk2(f[10], f[11]); w1.z = pk2(f[12], f[13]); w1.w = pk2(f[14], f[15]);
        *(u32x4*)d = w0; *(u32x4*)(d + 16) = w1;
        __syncthreads();
    }
}
struct TileSeq { int a0, sa, n1, b0, sb, n;
    __device__ __forceinline__ int at(int i) const { return i < n1 ? a0 + i * sa : b0 + (i - n1) * sb; } };
__device__ __forceinline__ void moe_weight_conversion(const Frame& F, int vb, int NC, int X) {
    const float* wgu = F.in[I_WGU]; const float* wdn = F.in[I_WDN]; unsigned char* dgu = F.ws + WS_WGU; unsigned char* ddn = F.ws + WS_WDN;
    LAS float* T = (LAS float*)F.lds; LAS float* GT = T + 128 * 65;
    __syncthreads();
    for (int i = F.tid; i < 1024; i += NTHREADS) GT[i] = F.in[I_GFFN][i];
    __syncthreads();
    TileSeq q; q.a0 = vb; q.sa = NC; q.n1 = (vb >= 0 && vb < X) ? (X - vb + NC - 1) / NC : 0; q.b0 = X + F.bid; q.sb = F.G; q.n = q.n1 + ((X + F.bid < MOE_TT) ? (MOE_TT - X - F.bid + F.G - 1) / F.G : 0);
    const int n = q.n;
    f32x4 va[4], vb4[4], vc[4];
    MoeTile mA = moe_tile(wgu, wdn, dgu, ddn, q.at(0 < n ? 0 : 0)), mB = moe_tile(wgu, wdn, dgu, ddn, q.at(1 < n ? 1 : 0)), mC = moe_tile(wgu, wdn, dgu, ddn, q.at(2 < n ? 2 : 0));
    if (n == 0) return;
    moe_tile_load(mA, F.tid, va); moe_tile_load(mB, F.tid, vb4); moe_tile_load(mC, F.tid, vc);
    int i = 0;
    for (; i + 5 < n; i += 3) {
        moe_tile_store(mA, F.tid, va, T, GT); mA = moe_tile(wgu, wdn, dgu, ddn, q.at(i + 3)); moe_tile_load(mA, F.tid, va);
        moe_tile_store(mB, F.tid, vb4, T, GT); mB = moe_tile(wgu, wdn, dgu, ddn, q.at(i + 4)); moe_tile_load(mB, F.tid, vb4);
        moe_tile_store(mC, F.tid, vc, T, GT); mC = moe_tile(wgu, wdn, dgu, ddn, q.at(i + 5)); moe_tile_load(mC, F.tid, vc);
    }
    for (; i < n; i += 3) {
        moe_tile_store(mA, F.tid, va, T, GT); if (i + 3 < n) { mA = moe_tile(wgu, wdn, dgu, ddn, q.at(i + 3)); moe_tile_load(mA, F.tid, va); }
        if (i + 1 < n) { moe_tile_store(mB, F.tid, vb4, T, GT); if (i + 4 < n) { mB = moe_tile(wgu, wdn, dgu, ddn, q.at(i + 4)); moe_tile_load(mB, F.tid, vb4); } }
        if (i + 2 < n) { moe_tile_store(mC, F.tid, vc, T, GT); if (i + 5 < n) { mC = moe_tile(wgu, wdn, dgu, ddn, q.at(i + 5)); moe_tile_load(mC, F.tid, vc); } }
    }
}

#if defined(TIMING_SCAFFOLD)
__device__ __forceinline__ void exp_stream_read(const Frame& F, int mode) {
    const float* src = F.in[I_WGU]; const size_t n4 = (size_t)NEXP * 1024 * 2048 / 4;
    f32x4 acc = {0.f, 0.f, 0.f, 0.f};
    if (mode == 1) {
        for (size_t i = (size_t)F.bid * NTHREADS + F.tid; i < n4; i += (size_t)F.G * NTHREADS * 8) {
#pragma unroll
            for (int u = 0; u < 8; ++u) { const size_t j = i + (size_t)u * F.G * NTHREADS; if (j < n4) acc += *(const f32x4*)(src + 4 * j); } }
    } else {
        const int r = F.tid >> 5, c4 = (F.tid & 31) * 4;
        for (int t = F.bid; t < MOE_T1; t += F.G) { const int e = t / 256, tile = t % 256, tk = tile % 16, tn = tile / 16;
            const float* s = src + (size_t)e * 1024 * 2048;
#pragma unroll
            for (int p = 0; p < 4; ++p) acc += *(const f32x4*)(s + (size_t)(tk * 64 + p * 16 + r) * 2048 + tn * 128 + c4); }
    }
    if (acc[0] + acc[1] + acc[2] + acc[3] == 1.2345e33f) F.out[0] = 0.f;
}
#endif

__device__ __forceinline__ void kmean_task(const Frame& F) {
    const float* XP = (const float*)(F.ws + WS_XPART); const bf16_t* W = (const bf16_t*)(F.ws + WS_WIN) + (size_t)C_K * DM; float* KM = (float*)(F.ws + WS_KM);
    for (int o = (F.bid * 8 + F.wave) * 12; o < 64 * 384; o += F.G * 8 * 12) {
        const int n = o / 384;
        float xb[16];
#pragma unroll
        for (int i = 0; i < 16; ++i) xb[i] = 0.f;
#pragma unroll
        for (int q = 0; q < 4; ++q)
#pragma unroll
            for (int j = 0; j < 4; ++j) { const f32x4 t = *(const f32x4*)(XP + (size_t)(4 * n + q) * 1024 + 16 * F.lane + 4 * j); xb[4 * j] += t[0]; xb[4 * j + 1] += t[1]; xb[4 * j + 2] += t[2]; xb[4 * j + 3] += t[3]; }
        u32x4 w0s[12], w1s[12];
#pragma unroll
        for (int i = 0; i < 12; ++i) { const int c = (o + i) % 384; w0s[i] = *(const u32x4*)(W + (size_t)c * DM + 16 * F.lane); w1s[i] = *(const u32x4*)(W + (size_t)c * DM + 16 * F.lane + 8); }
#pragma unroll
        for (int i = 0; i < 12; ++i) { const u32x4 w0 = w0s[i], w1 = w1s[i];
            float s = xb[0] * bflo(w0.x) + xb[1] * bfhi(w0.x) + xb[2] * bflo(w0.y) + xb[3] * bfhi(w0.y) + xb[4] * bflo(w0.z) + xb[5] * bfhi(w0.z) + xb[6] * bflo(w0.w) + xb[7] * bfhi(w0.w)
                    + xb[8] * bflo(w1.x) + xb[9] * bfhi(w1.x) + xb[10] * bflo(w1.y) + xb[11] * bfhi(w1.y) + xb[12] * bflo(w1.z) + xb[13] * bfhi(w1.z) + xb[14] * bflo(w1.w) + xb[15] * bfhi(w1.w);
            s = wave_sum(s); if (F.lane == 0) KM[o + i] = s * (1.0f / 256.0f); }
    }
}

__device__ __forceinline__ void router_phase(const Frame& F, bool dry = false) {
    const float* X1 = F.out; const float* wr = F.in[I_WR]; const float* gf = F.in[I_GFFN]; const float* br = F.in[I_BR];
    float* RS2 = (float*)(F.ws + WS_RS1 + 131072); float* TOPW = (float*)(F.ws + WS_TOPW); int* LIST = (int*)(F.ws + WS_LIST); unsigned* CNT = F.ctl();
    LAS float* W = (LAS float*)F.lds;
    LAS int* lcnt = (LAS int*)(F.lds + XTRA_OFF); LAS int* lbase = lcnt + 32; LAS int* lexp = lcnt + 64; LAS int* lrank = lcnt + 64 + 256;
    LAS float* LG = (LAS float*)(lcnt + 64 + 512); LAS float* SS = LG + 2 * 64 * 33;
#pragma unroll
    for (int it_ = 0; it_ < 16; ++it_) { const int i = F.tid + it_ * NTHREADS; const int k = i >> 3, e0 = (i & 7) * 4; f32x4 t = *(const f32x4*)(wr + 4 * i); t = t * gf[k];
        const int rho = (k & ~15) | ((k & 3) << 2) | ((k >> 2) & 3);
#pragma unroll
        for (int q = 0; q < 4; ++q) { const int e = e0 + q; W[rho * 32 + ((e & 15) << 1) + (e >> 4)] = t[q]; } }
    for (int g = F.bid; g < NTOK / 64; g += F.G) {
        if (F.tid < 32) lcnt[F.tid] = 0;
        __syncthreads();
        {
            const int i = F.lane & 15, kq = F.lane >> 4, tg = F.wave & 3, kh = F.wave >> 2; const float* xr = X1 + (size_t)(g * 64 + 16 * tg + i) * DM + 512 * kh + 4 * kq;
            f32x4 a0 = {0.f, 0.f, 0.f, 0.f}, a1 = {0.f, 0.f, 0.f, 0.f}; float ss = 0.f;
#pragma unroll 16
            for (int q = 0; q < 32; ++q) { const f32x4 xv = *(const f32x4*)(xr + 16 * q); ss += xv[0] * xv[0] + xv[1] * xv[1] + xv[2] * xv[2] + xv[3] * xv[3];
#pragma unroll
                for (int j = 0; j < 4; ++j) { const f32x2 b = *(const LAS f32x2*)(W + (512 * kh + 16 * q + 4 * j + kq) * 32 + 2 * i);
                    a0 = __builtin_amdgcn_mfma_f32_16x16x4f32(xv[j], b[0], a0, 0, 0, 0); a1 = __builtin_amdgcn_mfma_f32_16x16x4f32(xv[j], b[1], a1, 0, 0, 0); } }
            ss += __shfl_xor(ss, 16); ss += __shfl_xor(ss, 32);
            if (F.lane < 16) SS[kh * 64 + 16 * tg + i] = ss;
#pragma unroll
            for (int r = 0; r < 4; ++r) { LG[(kh * 64 + 16 * tg + 4 * kq + r) * 33 + i] = a0[r]; LG[(kh * 64 + 16 * tg + 4 * kq + r) * 33 + 16 + i] = a1[r]; }
        }
        __syncthreads();
        if (F.wave == 0) {
            const int tl = F.lane; const float rs = rsqrtf((SS[tl] + SS[64 + tl]) * (1.0f / DM) + 1e-5f);
            float lg[32];
#pragma unroll
            for (int q = 0; q < 32; ++q) lg[q] = (LG[tl * 33 + q] + LG[(64 + tl) * 33 + q]) * rs + br[q];
            float tv[4]; int te[4];
#pragma unroll
            for (int r = 0; r < 4; ++r) { float bv = -INFINITY; int bi = 0;
#pragma unroll
                for (int q = 0; q < 32; ++q) { const bool tk = lg[q] > bv; bv = tk ? lg[q] : bv; bi = tk ? q : bi; }
                tv[r] = bv; te[r] = bi;
#pragma unroll
                for (int q = 0; q < 32; ++q) lg[q] = (q == bi) ? -INFINITY : lg[q]; }
            const float e1 = __expf(tv[1] - tv[0]), e2 = __expf(tv[2] - tv[0]), e3 = __expf(tv[3] - tv[0]); const float inv = 1.0f / (1.0f + e1 + e2 + e3);
            *(f32x4*)(TOPW + (size_t)(g * 64 + tl) * 4) = (f32x4){inv, e1 * inv, e2 * inv, e3 * inv};
#pragma unroll
            for (int k = 0; k < 4; ++k) { lexp[tl * 4 + k] = te[k]; lrank[tl * 4 + k] = __hip_atomic_fetch_add(&lcnt[te[k]], 1, __ATOMIC_RELAXED, __HIP_MEMORY_SCOPE_WORKGROUP); }
            RS2[g * 64 + tl] = rs;
        }
        __syncthreads();
        if (F.tid < 32 && !dry) lbase[F.tid] = (int)atomicAdd(&CNT[F.tid], (unsigned)lcnt[F.tid]);
        __syncthreads();
        if (F.tid < 256 && !dry) { const int ek = lexp[F.tid]; LIST[(size_t)ek * NTOK + lbase[ek] + lrank[F.tid]] = g * 256 + F.tid; }
        __syncthreads();
    }
}

constexpr int MAXU = 16;
struct UTab { LAS int* meta; LAS int* rows; LAS int* pre; int nunits; };
__device__ __forceinline__ UTab build_unit_table(const Frame& F, int nN) {
    UTab T; T.pre = (LAS int*)(F.lds + XTRA_OFF); T.meta = T.pre + 80; T.rows = T.meta + MAXU * 4;
    const unsigned* CNT = F.ctl(); const int* LIST = (const int*)(F.ws + WS_LIST);
    LAS int* cnts = T.pre + 40;
    if (F.tid < NEXP) cnts[F.tid] = (int)CNT[F.tid];
    __syncthreads();
    if (F.tid == 0) { int s = 0; for (int e = 0; e < NEXP; ++e) { T.pre[e] = s; s += (cnts[e] + 255) >> 8; } T.pre[NEXP] = s; }
    __syncthreads();
    const int RT = T.pre[NEXP], U = RT * nN;
    int nu = 0;
    for (int i = 0; i < MAXU; ++i) { const int L = i * F.G + F.bid; if (L >= U) break;
        const int wgid = pg8::xcd_remap(L, U); const int rtg = wgid / nN, pn = wgid % nN;
        int e = 0; for (int q = 1; q < NEXP; ++q) if (T.pre[q] <= rtg) e = q;
        const int r = rtg - T.pre[e];
        if (F.tid == 0) { T.meta[i * 4] = e * nN + pn; T.meta[i * 4 + 1] = e; T.meta[i * 4 + 2] = pn; T.meta[i * 4 + 3] = r; }
        nu = i + 1; }
    __syncthreads();
    if (F.tid < 256) {
        int av[MAXU];
#pragma unroll
        for (int i = 0; i < MAXU; ++i) { av[i] = -1; if (i < nu) { const int e = T.meta[i * 4 + 1], r = T.meta[i * 4 + 3]; const int idx = r * 256 + F.tid; if (idx < cnts[e]) av[i] = LIST[(size_t)e * NTOK + idx]; } }
#pragma unroll
        for (int i = 0; i < MAXU; ++i) if (i < nu) T.rows[i * 256 + F.tid] = av[i];
    }
    __syncthreads();
    T.nunits = nu; return T;
}

__device__ __forceinline__ void final_phase(const Frame& F, bool dry = false) {
    const unsigned char* YE = F.ws + WS_YE; const float* gfin = F.in[I_GFIN]; float* out = F.out;
    f32x4 gv[4];
#pragma unroll
    for (int j = 0; j < 4; ++j) gv[j] = *(const f32x4*)(gfin + 16 * F.lane + 4 * j);
#pragma unroll 2
    for (int row = F.bid * 8 + F.wave; row < NTOK; row += F.G * 8) {
        float v[16];
#pragma unroll
        for (int j = 0; j < 4; ++j) { const f32x4 t = *(const f32x4*)(out + (size_t)row * DM + 16 * F.lane + 4 * j); v[4 * j] = t[0]; v[4 * j + 1] = t[1]; v[4 * j + 2] = t[2]; v[4 * j + 3] = t[3]; }
        if (YE_ESZ == 1) {
            u32x4 w[4];
#pragma unroll
            for (int k = 0; k < 4; ++k) w[k] = *(const u32x4*)(YE + (size_t)(row * 4 + k) * DM + 16 * F.lane);
#pragma unroll
            for (int k = 0; k < 4; ++k)
#pragma unroll
                for (int j = 0; j < 4; ++j) { const unsigned d = j == 0 ? w[k].x : j == 1 ? w[k].y : j == 2 ? w[k].z : w[k].w;
                    const f32x2 lo = __builtin_amdgcn_cvt_pk_f32_fp8(d, false), hi = __builtin_amdgcn_cvt_pk_f32_fp8(d, true);
                    v[4 * j] += lo[0] * (1.0f / YE_SCALE); v[4 * j + 1] += lo[1] * (1.0f / YE_SCALE); v[4 * j + 2] += hi[0] * (1.0f / YE_SCALE); v[4 * j + 3] += hi[1] * (1.0f / YE_SCALE); }
        } else {
#pragma unroll
            for (int k = 0; k < 4; ++k) { const u32x4 w0 = *(const u32x4*)(YE + ((size_t)(row * 4 + k) * DM + 16 * F.lane) * 2), w1 = *(const u32x4*)(YE + ((size_t)(row * 4 + k) * DM + 16 * F.lane + 8) * 2);
                v[0] += bflo(w0.x); v[1] += bfhi(w0.x); v[2] += bflo(w0.y); v[3] += bfhi(w0.y); v[4] += bflo(w0.z); v[5] += bfhi(w0.z); v[6] += bflo(w0.w); v[7] += bfhi(w0.w);
                v[8] += bflo(w1.x); v[9] += bfhi(w1.x); v[10] += bflo(w1.y); v[11] += bfhi(w1.y); v[12] += bflo(w1.z); v[13] += bfhi(w1.z); v[14] += bflo(w1.w); v[15] += bfhi(w1.w); }
        }
        float ss = 0.f;
#pragma unroll
        for (int i = 0; i < 16; ++i) ss += v[i] * v[i];
        ss = wave_sum(ss); const float rs = rsqrtf(ss * (1.0f / DM) + 1e-5f);
#pragma unroll
        for (int j = 0; j < 4; ++j) { f32x4 o; o[0] = v[4 * j] * rs * gv[j][0]; o[1] = v[4 * j + 1] * rs * gv[j][1]; o[2] = v[4 * j + 2] * rs * gv[j][2]; o[3] = v[4 * j + 3] * rs * gv[j][3];
            if (!dry) *(f32x4*)(out + (size_t)row * DM + 16 * F.lane + 4 * j) = o; else if (o[0] == 1.2345e30f) out[0] = 0.f; }
    }
}
__device__ __forceinline__ int crow(int r, int hi) { return (r & 3) + 8 * (r >> 2) + 4 * hi; }
constexpr int AT_KB = 0, AT_VB = 2 * 9216, AT_LUT = 4 * 9216, AT_UNIT = AT_LUT + 512;
constexpr float LOG2E = 1.4426950408889634f;

template <int MODE  >
__device__ __forceinline__ void attn_unit(const Frame& F, int b, int h, int qb) {
    const int lane = F.lane, wid = F.wave, r32 = lane & 31, hi = lane >> 5;
    const bf16_t* P = (const bf16_t*)(F.ws + WS_P); const bf16_t* MKV = (const bf16_t*)(F.ws + WS_MKV); bf16_t* Y = (bf16_t*)(F.ws + WS_Y);
    const size_t tok0 = (size_t)b * SEQ + (size_t)qb * 256;
    const bf16_t* Qp = P + tok0 * INC + (MODE ? C_Q : C_MQ) + h * 64;
    const bf16_t* Kb = MODE ? P + (size_t)b * SEQ * INC + C_K + h * 64 : MKV + (size_t)b * NMEM * 512 + h * 64;
    const bf16_t* Vb = MODE ? P + (size_t)b * SEQ * INC + C_V + h * 64 : MKV + (size_t)b * NMEM * 512 + 256 + h * 64;
    const int pkv = MODE ? INC : 512;
    const int nt = MODE ? 4 + 4 * qb : 4;
    LAS unsigned char* lds = F.lds;
    LAS float* LUT = (LAS float*)(lds + AT_LUT);
    auto tile_row = [&](int t) -> int { return MODE ? (t < 4 ? qb * 256 + 64 * t : 64 * (t - 4)) : 64 * t; };
    bf16x8 qf[4];
#pragma unroll
    for (int s = 0; s < 4; ++s) qf[s] = *(const bf16x8*)(Qp + (size_t)(32 * wid + r32) * INC + 16 * s + 8 * hi);
    unsigned selmask = 0xffu;
    if (MODE) {
        if (F.tid < 128) { const int n = F.tid; int bk = n; if (n >= 16) { bk = 16 + (int)(__logf((float)n * (1.0f / 16.0f)) / __logf(8.0f) * 16.0f); bk = bk > 31 ? 31 : bk; }
            const float* rb = F.in[I_RELB]; LUT[n] = (rb[bk * 6 + h] - rb[31 * 6 + h]) * LOG2E; }
        if (qb >= 4) {
            const float* KM = (const float*)(F.ws + WS_KM) + (size_t)(b * 8) * 384 + h * 64;
            float gate[7];
#pragma unroll
            for (int n = 0; n < 7; ++n) { float g = 0.f;
                if (n < qb) {
#pragma unroll
                    for (int s = 0; s < 4; ++s) { const f32x4 k0 = *(const f32x4*)(KM + n * 384 + 16 * s + 8 * hi), k1 = *(const f32x4*)(KM + n * 384 + 16 * s + 8 * hi + 4);
                        g += bf2f((unsigned short)qf[s][0]) * k0[0] + bf2f((unsigned short)qf[s][1]) * k0[1] + bf2f((unsigned short)qf[s][2]) * k0[2] + bf2f((unsigned short)qf[s][3]) * k0[3]
                           + bf2f((unsigned short)qf[s][4]) * k1[0] + bf2f((unsigned short)qf[s][5]) * k1[1] + bf2f((unsigned short)qf[s][6]) * k1[2] + bf2f((unsigned short)qf[s][7]) * k1[3]; }
                    g += __shfl_xor(g, 32);
                } else g = -INFINITY;
                gate[n] = g; }
            selmask = 0u;
#pragma unroll
            for (int r = 0; r < 3; ++r) { float bv = -INFINITY; int bi = 0;
#pragma unroll
                for (int n = 0; n < 7; ++n) { const bool take = !((selmask >> n) & 1u) && (gate[n] > bv); bv = take ? gate[n] : bv; bi = take ? n : bi; }
                selmask |= 1u << bi; }
        } else selmask = (1u << qb) - 1u;
    }
    u32x4 kreg, vreg;
    auto gload = [&](int t) { const size_t ro = (size_t)(tile_row(t) + lane) * pkv + 8 * wid; kreg = *(const u32x4*)(Kb + ro); vreg = *(const u32x4*)(Vb + ro); };
    auto lwrite = [&](int buf) {
        *(LAS u32x4*)(lds + AT_KB + buf * 9216 + lane * 144 + 16 * wid) = kreg;
        LAS unsigned short* vt = (LAS unsigned short*)(lds + AT_VB + buf * 9216) + (8 * wid) * 72 + lane;
        vt[0 * 72] = (unsigned short)(vreg.x & 0xffff); vt[1 * 72] = (unsigned short)(vreg.x >> 16); vt[2 * 72] = (unsigned short)(vreg.y & 0xffff); vt[3 * 72] = (unsigned short)(vreg.y >> 16);
        vt[4 * 72] = (unsigned short)(vreg.z & 0xffff); vt[5 * 72] = (unsigned short)(vreg.z >> 16); vt[6 * 72] = (unsigned short)(vreg.w & 0xffff); vt[7 * 72] = (unsigned short)(vreg.w >> 16); };
    gload(0); lwrite(0);
    __syncthreads();
    float m_run = -INFINITY, l_run = 0.f;
    f32x16 o0 = {}, o1 = {};
    const int qrel = 32 * wid + r32;
    constexpr float SC = 0.125f * LOG2E;
#pragma unroll 1
    for (int t = 0; t < nt; ++t) {
        if (t + 1 < nt) gload(t + 1);
        const int buf = t & 1;
        bool active = true; int nblk = 0, jb = t;
        if (MODE) { if (t < 4) active = (64 * t <= 32 * wid + 31); else { nblk = (t - 4) >> 2; jb = (t - 4) & 3; } }
        if (active) {
            const LAS unsigned char* kb = lds + AT_KB + buf * 9216;
            f32x16 s0 = {}, s1 = {};
#pragma unroll
            for (int s = 0; s < 4; ++s) { const bf16x8 k0 = *(const LAS bf16x8*)(kb + r32 * 144 + (16 * s + 8 * hi) * 2), k1 = *(const LAS bf16x8*)(kb + (32 + r32) * 144 + (16 * s + 8 * hi) * 2);
                s0 = __builtin_amdgcn_mfma_f32_32x32x16_bf16(k0, qf[s], s0, 0, 0, 0); s1 = __builtin_amdgcn_mfma_f32_32x32x16_bf16(k1, qf[s], s1, 0, 0, 0); }
            float mx;
            if (MODE) {
                if (t < 4) {
#pragma unroll
                    for (int r = 0; r < 16; ++r) { const int d0 = qrel - (64 * t + crow(r, hi)), d1 = d0 - 32;
                        const float l0 = LUT[d0 > 127 ? 127 : (d0 < 0 ? 0 : d0)], l1 = LUT[d1 > 127 ? 127 : (d1 < 0 ? 0 : d1)];
                        s0[r] = d0 >= 0 ? fmaf(s0[r], SC, l0) : -INFINITY; s1[r] = d1 >= 0 ? fmaf(s1[r], SC, l1) : -INFINITY; }
                } else {
                    const bool sel = (selmask >> nblk) & 1u;
                    if (nblk == qb - 1 && jb >= 2) {
#pragma unroll
                        for (int r = 0; r < 16; ++r) { const int d0 = 256 + qrel - (64 * jb + crow(r, hi)), d1 = d0 - 32;
                            const float l0 = LUT[d0 > 127 ? 127 : d0], l1 = LUT[d1 > 127 ? 127 : d1];
                            s0[r] = sel ? fmaf(s0[r], SC, l0) : -INFINITY; s1[r] = sel ? fmaf(s1[r], SC, l1) : -INFINITY; }
                    } else {
                        const float scl = sel ? SC : 0.f, off = sel ? 0.f : -INFINITY;
#pragma unroll
                        for (int r = 0; r < 16; ++r) { s0[r] = fmaf(s0[r], scl, off); s1[r] = fmaf(s1[r], scl, off); }
                    }
                }
            } else {
#pragma unroll
                for (int r = 0; r < 16; ++r) { s0[r] *= SC; s1[r] *= SC; }
            }
            mx = fmaxf(fmaxf(s0[0], s0[1]), s0[2]);
#pragma unroll
            for (int r = 3; r < 15; r += 2) mx = fmaxf(fmaxf(mx, s0[r]), s0[r + 1]);
            mx = fmaxf(mx, s0[15]);
#pragma unroll
            for (int r = 0; r < 16; r += 2) mx = fmaxf(fmaxf(mx, s1[r]), s1[r + 1]);
            mx = fmaxf(mx, __shfl_xor(mx, 32));
            const float m_new = fmaxf(m_run, mx);
            const float msafe = (m_new == -INFINITY) ? 0.f : m_new;
            const float alpha = __builtin_amdgcn_exp2f(m_run - msafe);
            float ps = 0.f;
#pragma unroll
            for (int r = 0; r < 16; ++r) { s0[r] = __builtin_amdgcn_exp2f(s0[r] - msafe); s1[r] = __builtin_amdgcn_exp2f(s1[r] - msafe); ps += s0[r] + s1[r]; }
            l_run = l_run * alpha + ps; m_run = m_new;
            if (alpha != 1.0f) {
#pragma unroll
                for (int r = 0; r < 16; ++r) { o0[r] *= alpha; o1[r] *= alpha; } }
            bf16x8 pf[2][2];
#pragma unroll
            for (int sp = 0; sp < 2; ++sp) {
                u32x4 a, c; a.x = pk2(s0[8 * sp], s0[8 * sp + 1]); a.y = pk2(s0[8 * sp + 2], s0[8 * sp + 3]); a.z = pk2(s0[8 * sp + 4], s0[8 * sp + 5]); a.w = pk2(s0[8 * sp + 6], s0[8 * sp + 7]);
                c.x = pk2(s1[8 * sp], s1[8 * sp + 1]); c.y = pk2(s1[8 * sp + 2], s1[8 * sp + 3]); c.z = pk2(s1[8 * sp + 4], s1[8 * sp + 5]); c.w = pk2(s1[8 * sp + 6], s1[8 * sp + 7]);
                pf[0][sp] = __builtin_bit_cast(bf16x8, a); pf[1][sp] = __builtin_bit_cast(bf16x8, c); }
            const LAS unsigned char* vb = lds + AT_VB + buf * 9216;
#pragma unroll
            for (int u = 0; u < 2; ++u)
#pragma unroll
                for (int sp = 0; sp < 2; ++sp) {
                    const int ko = (32 * u + 16 * sp + 4 * hi) * 2;
                    const u32x2 a0 = *(const LAS u32x2*)(vb + r32 * 144 + ko), a1 = *(const LAS u32x2*)(vb + r32 * 144 + ko + 16);
                    const u32x2 b0 = *(const LAS u32x2*)(vb + (32 + r32) * 144 + ko), b1 = *(const LAS u32x2*)(vb + (32 + r32) * 144 + ko + 16);
                    const u32x4 va = {a0.x, a0.y, a1.x, a1.y}, vb4 = {b0.x, b0.y, b1.x, b1.y};
                    o0 = __builtin_amdgcn_mfma_f32_32x32x16_bf16(__builtin_bit_cast(bf16x8, va), pf[u][sp], o0, 0, 0, 0);
                    o1 = __builtin_amdgcn_mfma_f32_32x32x16_bf16(__builtin_bit_cast(bf16x8, vb4), pf[u][sp], o1, 0, 0, 0); }
        }
        if (t + 1 < nt) lwrite(buf ^ 1);
        __syncthreads();
    }
    l_run += __shfl_xor(l_run, 32);
    const float inv = 1.0f / l_run;
    bf16_t* yp = Y + (tok0 + 32 * wid + r32) * DM + (MODE ? 0 : 768) + h * 64;
#pragma unroll
    for (int g = 0; g < 4; ++g) { u32x2 w0, w1; w0.x = pk2(o0[4 * g] * inv, o0[4 * g + 1] * inv); w0.y = pk2(o0[4 * g + 2] * inv, o0[4 * g + 3] * inv);
        w1.x = pk2(o1[4 * g] * inv, o1[4 * g + 1] * inv); w1.y = pk2(o1[4 * g + 2] * inv, o1[4 * g + 3] * inv);
        *(u32x2*)(yp + 8 * g + 4 * hi) = w0; *(u32x2*)(yp + 32 + 8 * g + 4 * hi) = w1; }
}

__device__ __forceinline__ void attention_phase(const Frame& F, int qslot) {
    LAS int* uslot = (LAS int*)(F.lds + AT_UNIT);
    for (;;) {
        if (F.tid == 0) uslot[0] = (int)atomicAdd(F.ctl() + qslot, 1u);
        __syncthreads();
        const int u = uslot[0];
        __syncthreads();
        if (u >= 640) break;
        if (u < 384) { const int qb = 7 - u / 48, bh = u % 48; attn_unit<1>(F, bh / 6, bh % 6, qb); }
        else { const int m = u - 384; attn_unit<0>(F, m >> 5, (m >> 3) & 3, m & 7); }
    }
}
constexpr int RS = 144;
constexpr int L_AT = 0, L_BT = 9216, L_KT = 18432, L_RT = 27648, L_BTT = 36864, L_CUM = 49152, L_AAK = 49152, L_ARB = 58368, L_TOT = 65536, L_KTT = 67584, L_VT = 76800,
              L_RHS = 86016, L_AABS = 118784, L_ARK = 135168, L_WAT = 86016, L_UVT = 95232, L_GC = 46080;
constexpr int L_LW = 0, L_LA = 16384, L_LG = 32768;
constexpr int RWU_MC = 0, RWU_QC = 8192, RWU_G1 = 16384, RWU_VB = 24576, RWU_NC = 32768, RWU_OL = 40960, RWU_BYTES = 49152;

__device__ __forceinline__ void mm_tile(f32x16& acc, const LAS unsigned char* Ab, int arow0, const LAS unsigned char* Bb, int brow0, int r32, int hi) {
#pragma unroll
    for (int s = 0; s < 4; ++s) { const bf16x8 a = *(const LAS bf16x8*)(Ab + (arow0 + r32) * RS + (16 * s + 8 * hi) * 2), b = *(const LAS bf16x8*)(Bb + (brow0 + r32) * RS + (16 * s + 8 * hi) * 2);
        acc = __builtin_amdgcn_mfma_f32_32x32x16_bf16(a, b, acc, 0, 0, 0); }
}
__device__ __forceinline__ float fast_tanh(float x) { const float e = __expf(2.0f * x); return 1.0f - 2.0f * __builtin_amdgcn_rcpf(e + 1.0f); }
__device__ __forceinline__ float fast_sigmoid(float x) { return __builtin_amdgcn_rcpf(1.0f + __expf(-x)); }
__device__ __forceinline__ void unpack8(const u32x4 w, float (&f)[8]) { f[0] = bflo(w.x); f[1] = bfhi(w.x); f[2] = bflo(w.y); f[3] = bfhi(w.y); f[4] = bflo(w.z); f[5] = bfhi(w.z); f[6] = bflo(w.w); f[7] = bfhi(w.w); }
__device__ __forceinline__ u32x4 pack8(const float (&f)[8]) { u32x4 w; w.x = pk2(f[0], f[1]); w.y = pk2(f[2], f[3]); w.z = pk2(f[4], f[5]); w.w = pk2(f[6], f[7]); return w; }

__device__ __forceinline__ void shifted8(const bf16_t* P, const float* mu, size_t tok, bool first, int col, float (&o)[8]) {
    float c[8], p[8]; unpack8(*(const u32x4*)(P + tok * INC + C_RW + col), c);
    if (!first) unpack8(*(const u32x4*)(P + (tok - 1) * INC + C_RW + col), p); else {
#pragma unroll
        for (int e = 0; e < 8; ++e) p[e] = 0.f; }
    const f32x4 m0 = *(const f32x4*)(mu + col), m1 = *(const f32x4*)(mu + col + 4);
#pragma unroll
    for (int e = 0; e < 8; ++e) o[e] = c[e] + (p[e] - c[e]) * (e < 4 ? m0[e] : m1[e - 4]);
}

struct Raw2 { u32x4 c, p; };
__device__ __forceinline__ Raw2 raw8(const bf16_t* P, size_t tok, bool first, int col) { Raw2 r; r.c = *(const u32x4*)(P + tok * INC + C_RW + col); r.p = first ? (u32x4){0u, 0u, 0u, 0u} : *(const u32x4*)(P + (tok - 1) * INC + C_RW + col); return r; }
__device__ __forceinline__ void mix8(const Raw2& r, const float* mu, int col, float (&o)[8]) {
    float c[8], p[8]; unpack8(r.c, c); unpack8(r.p, p);
    const f32x4 m0 = *(const f32x4*)(mu + col), m1 = *(const f32x4*)(mu + col + 4);
#pragma unroll
    for (int e = 0; e < 8; ++e) o[e] = c[e] + (p[e] - c[e]) * (e < 4 ? m0[e] : m1[e - 4]);
}
template <int QS> __device__ __forceinline__ float quad_bcast(float v) {
    return __builtin_bit_cast(float, __builtin_amdgcn_mov_dpp(__builtin_bit_cast(int, v), QS * 0x55, 0xf, 0xf, true));
}
template <int S> struct SolveStep {
    static __device__ __forceinline__ void run(float (&acc)[16], const LAS float* Aq  ) {
        constexpr int ms = S >> 2;
        const float xs = quad_bcast<S & 3>(acc[ms]);
        const LAS float* row = Aq + S * 64;
#pragma unroll
        for (int m4 = ms >> 2; m4 < 4; ++m4) { const f32x4 a = *(const LAS f32x4*)(row + 4 * m4);
#pragma unroll
            for (int e = 0; e < 4; ++e) if (4 * m4 + e >= ms) acc[4 * m4 + e] += a[e] * xs; }
        SolveStep<S + 1>::run(acc, Aq);
    }
};
template <> struct SolveStep<64> { static __device__ __forceinline__ void run(float (&)[16], const LAS float*) {} };

template <int CUT = 7> __device__ __forceinline__ void rwkv_chunk_unit(const Frame& F, int b, int h, int c, const bf16x8 (&fA)[8], Raw2 (&rw)[3]) {
    int tid = F.tid; asm volatile("" : "+v"(tid));
    const int lane = tid & 63, w = F.wave; int r32 = lane & 31, hi = lane >> 5;
    LAS unsigned char* lds = F.lds;
    const bf16_t* P = (const bf16_t*)(F.ws + WS_P); const float* mu = F.in[I_MU];
    const size_t T0 = (size_t)b * SEQ + (size_t)c * 64;
    unsigned char* ug = F.ws + WS_RW + (size_t)((b * 6 + h) * 32 + c) * RWU_BYTES;
    {
        const bf16_t* WU = (const bf16_t*)(F.ws + WS_LORA); const bf16_t* AU = WU + 384 * 64; const bf16_t* GU = WU + 2 * 384 * 64;
        const int rt = (w & 3) >> 1, ct = w & 1;
        const int jrow = h * 64 + 32 * ct + r32;
        if (w < 4) {
            f32x16 aw = {}, aa = {};
#pragma unroll
            for (int s = 0; s < 4; ++s) {
                const bf16x8 bw = *(const bf16x8*)(WU + (size_t)jrow * 64 + 16 * s + 8 * hi), ba = *(const bf16x8*)(AU + (size_t)jrow * 64 + 16 * s + 8 * hi);
                aw = __builtin_amdgcn_mfma_f32_32x32x16_bf16(fA[s], bw, aw, 0, 0, 0); aa = __builtin_amdgcn_mfma_f32_32x32x16_bf16(fA[4 + s], ba, aa, 0, 0, 0); }
#pragma unroll
            for (int r = 0; r < 16; ++r) { const int o = (32 * rt + crow(r, hi)) * 64 + 32 * ct + r32; ((LAS float*)(lds + L_LW))[o] = aw[r]; ((LAS float*)(lds + L_LA))[o] = aa[r]; }
        } else {
            f32x16 ag = {};
#pragma unroll
            for (int s = 0; s < 8; ++s) { const bf16x8 bg = *(const bf16x8*)(GU + (size_t)jrow * 128 + 16 * s + 8 * hi);
                ag = __builtin_amdgcn_mfma_f32_32x32x16_bf16(fA[s], bg, ag, 0, 0, 0); }
#pragma unroll
            for (int r = 0; r < 16; ++r) ((LAS float*)(lds + L_LG))[(32 * rt + crow(r, hi)) * 64 + 32 * ct + r32] = ag[r];
        }
    }
    __syncthreads();
    if (CUT <= 1) return;
    const int t = tid >> 3, j0 = (tid & 7) * 8, hj = h * 64 + j0;
    float rr[8], km[8], vv[8], av[8], bv[8], lw[8], gg[8], bonus;
    {
        const size_t tok = T0 + t; const bool first = (c == 0 && t == 0);
        float kx[8];
        mix8(rw[0], mu, RW_R + hj, rr); mix8(rw[1], mu, RW_K + hj, kx); mix8(rw[2], mu, RW_V + hj, vv);
        if (h < 5) { rw[0] = raw8(P, tok, first, RW_R + hj + 64); rw[1] = raw8(P, tok, first, RW_K + hj + 64); rw[2] = raw8(P, tok, first, RW_V + hj + 64); }
        const float* w0 = F.in[I_W0] + hj; const float* a0 = F.in[I_A0] + hj; const float* kkp = F.in[I_KK] + hj; const float* kap = F.in[I_KA] + hj; const float* rkp = F.in[I_RK] + hj;
        float asg[8], kk[8], ss = 0.f, bs = 0.f;
#pragma unroll
        for (int e = 0; e < 8; ++e) {
            const float z = -(w0[e] + ((const LAS float*)(lds + L_LW))[t * 64 + j0 + e]);
            const float sp = fmaxf(z, 0.f) + __logf(1.0f + __expf(-fabsf(z)));
            lw[e] = -__expf(-sp - 0.5f);
            asg[e] = fast_sigmoid(a0[e] + ((const LAS float*)(lds + L_LA))[t * 64 + j0 + e]);
            gg[e] = ((const LAS float*)(lds + L_LG))[t * 64 + j0 + e];
            kk[e] = kx[e] * kkp[e]; ss += kk[e] * kk[e];
            km[e] = kx[e] * (1.0f + (asg[e] - 1.0f) * kap[e]);
            bs += rr[e] * km[e] * rkp[e];
        }
        ss += __shfl_xor(ss, 1); ss += __shfl_xor(ss, 2); ss += __shfl_xor(ss, 4);
        bs += __shfl_xor(bs, 1); bs += __shfl_xor(bs, 2); bs += __shfl_xor(bs, 4);
        bonus = bs;
        const float inv = 1.0f / fmaxf(sqrtf(ss), 1e-12f);
#pragma unroll
        for (int e = 0; e < 8; ++e) { const float kn = kk[e] * inv; av[e] = -kn; bv[e] = kn * asg[e]; }
    }
    __syncthreads();
    { LAS float* cum = (LAS float*)(lds + L_CUM) + t * 64 + j0; *(LAS f32x4*)cum = (f32x4){lw[0], lw[1], lw[2], lw[3]}; *(LAS f32x4*)(cum + 4) = (f32x4){lw[4], lw[5], lw[6], lw[7]}; }
    __syncthreads();
    {
        const int jc = tid & 63, seg = tid >> 6; LAS float* cum = (LAS float*)(lds + L_CUM); LAS float* tot = (LAS float*)(lds + L_TOT);
        float pre[8]; float s = 0.f;
#pragma unroll
        for (int u = 0; u < 8; ++u) { s += cum[(8 * seg + u) * 64 + jc]; pre[u] = s; }
        tot[seg * 64 + jc] = s;
        __syncthreads();
        float off = 0.f;
#pragma unroll
        for (int q = 0; q < 8; ++q) if (q < seg) off += tot[q * 64 + jc];
#pragma unroll
        for (int u = 0; u < 8; ++u) cum[(8 * seg + u) * 64 + jc] = off + pre[u];
    }
    __syncthreads();
    {
        float Li[8]; { const LAS float* cum = (const LAS float*)(lds + L_CUM) + t * 64 + j0; const f32x4 a = *(const LAS f32x4*)cum, b2 = *(const LAS f32x4*)(cum + 4);
            Li[0] = a[0]; Li[1] = a[1]; Li[2] = a[2]; Li[3] = a[3]; Li[4] = b2[0]; Li[5] = b2[1]; Li[6] = b2[2]; Li[7] = b2[3]; }
        float At[8], Bt[8], Kt[8], Rt[8];
#pragma unroll
        for (int e = 0; e < 8; ++e) { const float gi = __expf(-Li[e]); At[e] = av[e] * __expf(Li[e] - lw[e]); Bt[e] = bv[e] * gi; Kt[e] = km[e] * gi; Rt[e] = rr[e] * __expf(Li[e]); }
        if (t == 63) {
#pragma unroll
            for (int e = 0; e < 8; ++e) ((LAS float*)(lds + L_GC))[j0 + e] = __expf(Li[e]); }
        __syncthreads();
        *(LAS u32x4*)(lds + L_AT + t * RS + j0 * 2) = pack8(At); *(LAS u32x4*)(lds + L_BT + t * RS + j0 * 2) = pack8(Bt);
        *(LAS u32x4*)(lds + L_KT + t * RS + j0 * 2) = pack8(Kt); *(LAS u32x4*)(lds + L_RT + t * RS + j0 * 2) = pack8(Rt);
#pragma unroll
        for (int e = 0; e < 8; ++e) { *(LAS unsigned short*)(lds + L_BTT + (j0 + e) * RS + 2 * t) = (unsigned short)f2bf(Bt[e]); *(LAS unsigned short*)(lds + L_KTT + (j0 + e) * RS + 2 * t) = (unsigned short)f2bf(Kt[e]);
            *(LAS unsigned short*)(lds + L_VT + (j0 + e) * RS + 2 * t) = (unsigned short)f2bf(vv[e]); }
        { LAS float* rhs = (LAS float*)(lds + L_RHS) + t * 128 + j0; *(LAS f32x4*)rhs = (f32x4){At[0], At[1], At[2], At[3]}; *(LAS f32x4*)(rhs + 4) = (f32x4){At[4], At[5], At[6], At[7]}; }
        const float* gng = F.in[I_GNG] + hj; const float* gnb = F.in[I_GNB] + hj;
        float g1[8], vb[8];
#pragma unroll
        for (int e = 0; e < 8; ++e) { g1[e] = gng[e] * gg[e]; vb[e] = (gnb[e] + bonus * vv[e]) * gg[e]; }
        const int it = j0 >> 5, tt = t >> 5, rb = 4 * ((j0 >> 3) & 3);
        bf16_t* g1p = (bf16_t*)(ug + RWU_G1) + ((size_t)((it * 2 + tt) * 64 + (t & 31)) * 16 + rb); bf16_t* vbp = (bf16_t*)(ug + RWU_VB) + ((size_t)((it * 2 + tt) * 64 + (t & 31)) * 16 + rb);
        { u32x2 x; x.x = pk2(g1[0], g1[1]); x.y = pk2(g1[2], g1[3]); *(u32x2*)g1p = x; x.x = pk2(g1[4], g1[5]); x.y = pk2(g1[6], g1[7]); *(u32x2*)(g1p + 32 * 16) = x; }
        { u32x2 x; x.x = pk2(vb[0], vb[1]); x.y = pk2(vb[2], vb[3]); *(u32x2*)vbp = x; x.x = pk2(vb[4], vb[5]); x.y = pk2(vb[6], vb[7]); *(u32x2*)(vbp + 32 * 16) = x; }
    }
    __syncthreads();
    if (CUT <= 3) return;
    asm volatile("" : "+v"(r32), "+v"(hi));
    {
        const int p = w >> 1, ct = w & 1; const LAS unsigned char* Ab = lds + ((p & 1) ? L_KT : L_BT); const LAS unsigned char* Bb = lds + ((p >> 1) ? L_RT : L_AT);
#pragma unroll
        for (int rs_ = 0; rs_ < 2; ++rs_) { f32x16 d = {}; mm_tile(d, Ab, 32 * rs_, Bb, 32 * ct, r32, hi);
            const int tq = 32 * ct + r32;
#pragma unroll
            for (int r = 0; r < 16; ++r) { const int s = 32 * rs_ + crow(r, hi); const bool keep = (p >> 1) ? (s <= tq) : (s < tq); d[r] = keep ? d[r] : 0.f; }
            if (p == 0) {
#pragma unroll
                for (int r = 0; r < 16; ++r) { const int s = 32 * rs_ + crow(r, hi); ((LAS float*)(lds + L_AABS))[(s * 4 + (tq & 3)) * 16 + (tq >> 2)] = d[r]; }
            } else { LAS unsigned char* dst = lds + (p == 1 ? L_AAK : p == 2 ? L_ARB : L_ARK) + tq * RS;
#pragma unroll
                for (int g = 0; g < 4; ++g) { u32x2 x; x.x = pk2(d[4 * g], d[4 * g + 1]); x.y = pk2(d[4 * g + 2], d[4 * g + 3]); *(LAS u32x2*)(dst + (32 * rs_ + 8 * g + 4 * hi) * 2) = x; } }
        }
    }
    __syncthreads();
    asm volatile("" : "+v"(r32), "+v"(hi));
    if (w < 4) {
        const int rt = w >> 1, ct = w & 1; f32x16 d = {}; mm_tile(d, lds + L_AAK, 32 * rt, lds + L_VT, 32 * ct, r32, hi);
#pragma unroll
        for (int r = 0; r < 16; ++r) ((LAS float*)(lds + L_RHS))[(32 * rt + crow(r, hi)) * 128 + 64 + 32 * ct + r32] = d[r];
    }
    __syncthreads();
    if (CUT <= 5) return;
    {
        int l2 = lane; asm volatile("" : "+v"(l2)); const int col = 16 * w + (l2 >> 2), q = l2 & 3; float acc[16];
#pragma unroll
        for (int m = 0; m < 16; ++m) acc[m] = ((const LAS float*)(lds + L_RHS))[(4 * m + q) * 128 + col];
        __syncthreads();
        SolveStep<0>::run(acc, (const LAS float*)(lds + L_AABS) + q * 16);
        LAS unsigned char* dst = lds + (col < 64 ? L_WAT + col * RS : L_UVT + (col - 64) * RS);
#pragma unroll
        for (int m = 0; m < 16; ++m) *(LAS unsigned short*)(dst + (4 * m + q) * 2) = (unsigned short)f2bf(acc[m]);
    }
    __syncthreads();
    if (CUT <= 6) return;
    asm volatile("" : "+v"(r32), "+v"(hi));
    {
        const int ta = (w & 3) >> 1, tb = w & 1; const int tile = ta * 2 + tb;
        const LAS float* gc = (const LAS float*)(lds + L_GC);
        if (w < 4) {
            f32x16 d = {}; mm_tile(d, lds + L_WAT, 32 * ta, lds + L_BTT, 32 * tb, r32, hi);
            const float gcl = gc[32 * tb + r32]; float f[16];
#pragma unroll
            for (int r = 0; r < 16; ++r) f[r] = (d[r] + ((32 * ta + crow(r, hi)) == (32 * tb + r32) ? 1.0f : 0.f)) * gcl;
            u32x4 x0, x1; x0.x = pk2(f[0], f[1]); x0.y = pk2(f[2], f[3]); x0.z = pk2(f[4], f[5]); x0.w = pk2(f[6], f[7]); x1.x = pk2(f[8], f[9]); x1.y = pk2(f[10], f[11]); x1.z = pk2(f[12], f[13]); x1.w = pk2(f[14], f[15]);
            u32x4* o = (u32x4*)(ug + RWU_MC + (size_t)(tile * 64 + lane) * 32); o[0] = x0; o[1] = x1;
            f32x16 n = {}; mm_tile(n, lds + L_BTT, 32 * ta, lds + L_UVT, 32 * tb, r32, hi); mm_tile(n, lds + L_KTT, 32 * ta, lds + L_VT, 32 * tb, r32, hi);
            float nf[16];
#pragma unroll
            for (int r = 0; r < 16; ++r) nf[r] = n[r] * gc[32 * ta + crow(r, hi)];
            { u32x4 y0, y1; y0.x = pk2(nf[0], nf[1]); y0.y = pk2(nf[2], nf[3]); y0.z = pk2(nf[4], nf[5]); y0.w = pk2(nf[6], nf[7]); y1.x = pk2(nf[8], nf[9]); y1.y = pk2(nf[10], nf[11]); y1.z = pk2(nf[12], nf[13]); y1.w = pk2(nf[14], nf[15]);
              u32x4* on = (u32x4*)(ug + RWU_NC + (size_t)(tile * 64 + lane) * 32); on[0] = y0; on[1] = y1; }
        } else {
            f32x16 d = {}; mm_tile(d, lds + L_WAT, 32 * ta, lds + L_ARB, 32 * tb, r32, hi);
            float f[16];
#pragma unroll
            for (int g = 0; g < 4; ++g) { const u32x2 rv = *(const LAS u32x2*)(lds + L_RT + (32 * tb + r32) * RS + (32 * ta + 8 * g + 4 * hi) * 2);
                f[4 * g] = d[4 * g] + bflo(rv.x); f[4 * g + 1] = d[4 * g + 1] + bfhi(rv.x); f[4 * g + 2] = d[4 * g + 2] + bflo(rv.y); f[4 * g + 3] = d[4 * g + 3] + bfhi(rv.y); }
            u32x4 x0, x1; x0.x = pk2(f[0], f[1]); x0.y = pk2(f[2], f[3]); x0.z = pk2(f[4], f[5]); x0.w = pk2(f[6], f[7]); x1.x = pk2(f[8], f[9]); x1.y = pk2(f[10], f[11]); x1.z = pk2(f[12], f[13]); x1.w = pk2(f[14], f[15]);
            u32x4* o = (u32x4*)(ug + RWU_QC + (size_t)(tile * 64 + lane) * 32); o[0] = x0; o[1] = x1;
            f32x16 n = {}; mm_tile(n, lds + L_UVT, 32 * ta, lds + L_ARB, 32 * tb, r32, hi); mm_tile(n, lds + L_VT, 32 * ta, lds + L_ARK, 32 * tb, r32, hi);
            { u32x4 y0, y1; y0.x = pk2(n[0], n[1]); y0.y = pk2(n[2], n[3]); y0.z = pk2(n[4], n[5]); y0.w = pk2(n[6], n[7]); y1.x = pk2(n[8], n[9]); y1.y = pk2(n[10], n[11]); y1.z = pk2(n[12], n[13]); y1.w = pk2(n[14], n[15]);
              u32x4* on = (u32x4*)(ug + RWU_OL + (size_t)(tile * 64 + lane) * 32); on[0] = y0; on[1] = y1; }
        }
    }
    __syncthreads();
}

template <int CUT = 7> __device__ __forceinline__ void rwkv_chunk_phase(const Frame& F) {
    const bf16_t* P = (const bf16_t*)(F.ws + WS_P); const float* mu = F.in[I_MU];
    for (int su = F.bid; su < NB * 32; su += F.G) { const int b = su >> 5, c = su & 31;
        int tid = F.tid; asm volatile("" : "+v"(tid));
        const int lane = tid & 63, w = F.wave, r32 = lane & 31, hi = lane >> 5;
        const size_t T0 = (size_t)b * SEQ + (size_t)c * 64;
        bf16x8 fA[8];
        { const int rt = (w & 3) >> 1; const size_t tok = T0 + 32 * rt + r32; const bool first = (c == 0 && rt == 0 && r32 == 0);
          if (w < 4) {
#pragma unroll
              for (int s = 0; s < 4; ++s) { float xw[8], xa[8]; shifted8(P, mu, tok, first, RW_XW + 16 * s + 8 * hi, xw); shifted8(P, mu, tok, first, RW_XA + 16 * s + 8 * hi, xa);
#pragma unroll
                  for (int e = 0; e < 8; ++e) xw[e] = fast_tanh(xw[e]);
                  fA[s] = __builtin_bit_cast(bf16x8, pack8(xw)); fA[4 + s] = __builtin_bit_cast(bf16x8, pack8(xa)); }
          } else {
#pragma unroll
              for (int s = 0; s < 8; ++s) { float xg[8]; shifted8(P, mu, tok, first, RW_XG + 16 * s + 8 * hi, xg);
#pragma unroll
                  for (int e = 0; e < 8; ++e) xg[e] = fast_sigmoid(xg[e]);
                  fA[s] = __builtin_bit_cast(bf16x8, pack8(xg)); }
          } }
        Raw2 rw[3];
        { const int t = tid >> 3, j0 = (tid & 7) * 8; const size_t tok = T0 + t; const bool first = (c == 0 && t == 0);
          rw[0] = raw8(P, tok, first, RW_R + j0); rw[1] = raw8(P, tok, first, RW_K + j0); rw[2] = raw8(P, tok, first, RW_V + j0); }
#pragma unroll 1
        for (int h = 0; h < 6; ++h) rwkv_chunk_unit<CUT>(F, b, h, c, fA, rw);
    }
}

__device__ __forceinline__ bf16x8 acc_frag(const f32x16& a, int s) {
    u32x4 x; x.x = pk2(a[8 * s], a[8 * s + 1]); x.y = pk2(a[8 * s + 2], a[8 * s + 3]); x.z = pk2(a[8 * s + 4], a[8 * s + 5]); x.w = pk2(a[8 * s + 6], a[8 * s + 7]); return __builtin_bit_cast(bf16x8, x);
}
__device__ __forceinline__ f32x16 lds_acc(const LAS unsigned char* p) { const LAS u32x4* q = (const LAS u32x4*)p; const u32x4 a = q[0], b = q[1];
    return (f32x16){bflo(a.x), bfhi(a.x), bflo(a.y), bfhi(a.y), bflo(a.z), bfhi(a.z), bflo(a.w), bfhi(a.w), bflo(b.x), bfhi(b.x), bflo(b.y), bfhi(b.y), bflo(b.z), bfhi(b.z), bflo(b.w), bfhi(b.w)}; }

constexpr int SC_HB = 2 * RWU_BYTES;
__device__ __forceinline__ void rwkv_scan(const Frame& F, int b, int h) {
    const int tid = F.tid, lane = F.lane, r32 = lane & 31, hi = lane >> 5, wv = F.wave;
    LAS unsigned char* lds = F.lds;
    const unsigned char* ug = F.ws + WS_RW + (size_t)((b * 6 + h) * 32) * RWU_BYTES;
    bf16_t* Y = (bf16_t*)(F.ws + WS_Y);
    {
        u32x4 st[6];
#pragma unroll
        for (int k = 0; k < 6; ++k) st[k] = *(const u32x4*)(ug + (size_t)(k * NTHREADS + tid) * 16);
#pragma unroll
        for (int k = 0; k < 6; ++k) *(LAS u32x4*)(lds + (k * NTHREADS + tid) * 16) = st[k];
        *(LAS u32x4*)(lds + SC_HB + tid * 16) = (u32x4){0u, 0u, 0u, 0u};
    }
    if (wv >= 3) {
        const int t5 = tid - 192; u32x4 st[10];
#pragma unroll
        for (int k = 0; k < 10; ++k) { const int pc = k * 320 + t5; if (pc < 3072) st[k] = *(const u32x4*)(ug + (size_t)RWU_BYTES + (size_t)pc * 16); }
#pragma unroll 1
        for (int c = 0; c < 32; ++c) {
            __syncthreads();
            if (c + 1 < 32) { LAS unsigned char* dst = lds + ((c + 1) & 1) * RWU_BYTES;
#pragma unroll
                for (int k = 0; k < 10; ++k) { const int pc = k * 320 + t5; if (pc < 3072) *(LAS u32x4*)(dst + pc * 16) = st[k]; } }
            if (c + 2 < 32) { const unsigned char* src = ug + (size_t)(c + 2) * RWU_BYTES;
#pragma unroll
                for (int k = 0; k < 10; ++k) { const int pc = k * 320 + t5; if (pc < 3072) st[k] = *(const u32x4*)(src + (size_t)pc * 16); } }
        }
    } else if (wv == 0) {
        f32x16 H[2][2];
#pragma unroll
        for (int a = 0; a < 2; ++a)
#pragma unroll
            for (int c2 = 0; c2 < 2; ++c2) H[a][c2] = (f32x16){};
#pragma unroll 1
        for (int c = 0; c < 32; ++c) {
            __syncthreads();
            const LAS unsigned char* B = lds + (c & 1) * RWU_BYTES;
            bf16x8 hb[2][2][2];
#pragma unroll
            for (int jt = 0; jt < 2; ++jt)
#pragma unroll
                for (int it = 0; it < 2; ++it)
#pragma unroll
                    for (int s = 0; s < 2; ++s) hb[jt][it][s] = acc_frag(H[jt][it], s);
#pragma unroll
            for (int rt = 0; rt < 2; ++rt)
#pragma unroll
                for (int it = 0; it < 2; ++it) { __builtin_amdgcn_sched_barrier(0); f32x16 a = lds_acc(B + RWU_NC + ((rt * 2 + it) * 64 + lane) * 32);
#pragma unroll
                    for (int kt = 0; kt < 2; ++kt)
#pragma unroll
                        for (int s = 0; s < 2; ++s) { const bf16x8 m = *(const LAS bf16x8*)(B + RWU_MC + ((kt * 2 + rt) * 64 + lane) * 32 + 16 * s);
                            a = __builtin_amdgcn_mfma_f32_32x32x16_bf16(m, hb[kt][it][s], a, 0, 0, 0); }
                    H[rt][it] = a; }
            if (c + 1 < 32) {
                LAS unsigned char* HN = lds + SC_HB + ((c + 1) & 1) * 8192;
#pragma unroll
                for (int jt = 0; jt < 2; ++jt)
#pragma unroll
                    for (int it = 0; it < 2; ++it)
#pragma unroll
                        for (int s = 0; s < 2; ++s) *(LAS bf16x8*)(HN + ((((jt * 2 + it) * 2 + s) * 64) + lane) * 16) = acc_frag(H[jt][it], s);
            }
        }
    } else {
        const int tt = wv - 1;
#pragma unroll 1
        for (int c = 0; c < 32; ++c) {
            __syncthreads();
            const LAS unsigned char* B = lds + (c & 1) * RWU_BYTES;
            const LAS unsigned char* HB = lds + SC_HB + (c & 1) * 8192;
            f32x16 O[2];
#pragma unroll
            for (int it = 0; it < 2; ++it) { f32x16 a = lds_acc(B + RWU_OL + ((it * 2 + tt) * 64 + lane) * 32);
#pragma unroll
                for (int kt = 0; kt < 2; ++kt)
#pragma unroll
                    for (int s = 0; s < 2; ++s) { const bf16x8 q = *(const LAS bf16x8*)(B + RWU_QC + ((kt * 2 + tt) * 64 + lane) * 32 + 16 * s);
                        const bf16x8 hf = *(const LAS bf16x8*)(HB + ((((kt * 2 + it) * 2 + s) * 64) + lane) * 16);
                        a = __builtin_amdgcn_mfma_f32_32x32x16_bf16(hf, q, a, 0, 0, 0); }
                O[it] = a; }
            float s1 = 0.f;
#pragma unroll
            for (int r = 0; r < 16; ++r) s1 += O[0][r] + O[1][r];
            s1 += __shfl_xor(s1, 32); const float mean = s1 * (1.0f / 64.0f);
            float s2 = 0.f;
#pragma unroll
            for (int r = 0; r < 16; ++r) { const float d0 = O[0][r] - mean, d1 = O[1][r] - mean; s2 += d0 * d0 + d1 * d1; }
            s2 += __shfl_xor(s2, 32); const float rstd = rsqrtf(s2 * (1.0f / 64.0f) + 64e-5f);
            bf16_t* yp = Y + ((size_t)b * SEQ + c * 64 + 32 * tt + r32) * DM + 384 + h * 64;
#pragma unroll
            for (int it = 0; it < 2; ++it) {
                const LAS u32x2* g1 = (const LAS u32x2*)(B + RWU_G1 + ((it * 2 + tt) * 64 + lane) * 32); const LAS u32x2* vb = (const LAS u32x2*)(B + RWU_VB + ((it * 2 + tt) * 64 + lane) * 32);
#pragma unroll
                for (int g = 0; g < 4; ++g) { const u32x2 gw = g1[g], vw = vb[g];
                    const float y0 = (O[it][4 * g] - mean) * rstd * bflo(gw.x) + bflo(vw.x), y1 = (O[it][4 * g + 1] - mean) * rstd * bfhi(gw.x) + bfhi(vw.x);
                    const float y2 = (O[it][4 * g + 2] - mean) * rstd * bflo(gw.y) + bflo(vw.y), y3 = (O[it][4 * g + 3] - mean) * rstd * bfhi(gw.y) + bfhi(vw.y);
                    u32x2 x; x.x = pk2(y0, y1); x.y = pk2(y2, y3); *(u32x2*)(yp + 32 * it + 8 * g + 4 * hi) = x; }
            }
        }
    }
    __syncthreads();
}
#if defined(SELFCHECK)
__device__ __forceinline__ int t5_bucket_dev(int n) { if (n < 16) return n; int bk = 16 + (int)(logf((float)n / 16.0f) / logf(8.0f) * 16.0f); return bk > 31 ? 31 : bk; }

__device__ __forceinline__ void check_attention(const Frame& F) {
    const bf16_t* P = (const bf16_t*)(F.ws + WS_P); const bf16_t* MKV = (const bf16_t*)(F.ws + WS_MKV); const bf16_t* Y = (const bf16_t*)(F.ws + WS_Y);
    LAS float* sc = (LAS float*)F.lds + F.wave * 2048;
    const int lane = F.lane;
    for (int rep = 0; rep < 2; ++rep) {
        const int sidx = (rep * F.G + F.bid) * 8 + F.wave;
        const int b = sidx % 8, h = (sidx / 8) % 6, s = (sidx * 977 + 123) % 2048, qb = s >> 8;
        const size_t tok = (size_t)b * SEQ + s;
        {
            float qall[64];
#pragma unroll
            for (int d = 0; d < 64; ++d) qall[d] = bf2f(P[tok * INC + C_Q + h * 64 + d]);
            const float qv = bf2f(P[tok * INC + C_Q + h * 64 + lane]);
            float gate[8]; unsigned mask = 0;
#pragma unroll
            for (int n = 0; n < 8; ++n) { gate[n] = -INFINITY;
                if (n < qb) { float km = 0.f; for (int j = 0; j < 256; ++j) km += bf2f(P[((size_t)b * SEQ + n * 256 + j) * INC + C_K + h * 64 + lane]); gate[n] = wave_sum(qv * km * (1.0f / 256.0f)); } }
            if (qb <= 3) mask = (1u << qb) - 1u; else {
#pragma unroll
                for (int r = 0; r < 3; ++r) { float bv = -INFINITY; int bi = 0;
#pragma unroll
                    for (int n = 0; n < 8; ++n) { const bool take = !((mask >> n) & 1u) && gate[n] > bv; bv = take ? gate[n] : bv; bi = take ? n : bi; }
                    mask |= 1u << bi; } }
            float mx = -INFINITY;
            for (int j = lane; j <= s; j += 64) { const int nk = j >> 8; const bool ok = (nk == qb) || ((mask >> nk) & 1u);
                float dot = 0.f; const bf16_t* kp = P + ((size_t)b * SEQ + j) * INC + C_K + h * 64;
#pragma unroll
                for (int d = 0; d < 64; ++d) dot += qall[d] * bf2f(kp[d]);
                const float v = ok ? dot * 0.125f + F.in[I_RELB][t5_bucket_dev(s - j) * 6 + h] : -INFINITY; sc[j] = v; mx = fmaxf(mx, v); }
#pragma unroll
            for (int o = 32; o >= 1; o >>= 1) mx = fmaxf(mx, __shfl_xor(mx, o));
            float sum = 0.f;
            for (int j = lane; j <= s; j += 64) { const float p = __expf(sc[j] - mx); sc[j] = p; sum += p; }
            sum = wave_sum(sum);
            float o = 0.f;
            for (int j = 0; j <= s; ++j) { const float p = sc[j]; if (p != 0.f) o += p * bf2f(P[((size_t)b * SEQ + j) * INC + C_V + h * 64 + lane]); }
            o /= sum;
            const float y = bf2f(Y[tok * DM + h * 64 + lane]);
            const float e2 = wave_sum((y - o) * (y - o)), r2 = wave_sum(o * o);
            if (lane == 0 && !(e2 <= 0.0009f * r2 + 1e-12f)) atomicAdd(F.ctl() + 48, 1u);
        }
        if (h < 4) {
            float qall[64];
#pragma unroll
            for (int d = 0; d < 64; ++d) qall[d] = bf2f(P[tok * INC + C_MQ + h * 64 + d]);
            float mx = -INFINITY;
            for (int j = lane; j < 256; j += 64) { float dot = 0.f; const bf16_t* kp = MKV + ((size_t)b * NMEM + j) * 512 + h * 64;
#pragma unroll
                for (int d = 0; d < 64; ++d) dot += qall[d] * bf2f(kp[d]);
                sc[j] = dot * 0.125f; mx = fmaxf(mx, dot * 0.125f); }
#pragma unroll
            for (int o = 32; o >= 1; o >>= 1) mx = fmaxf(mx, __shfl_xor(mx, o));
            float sum = 0.f;
            for (int j = lane; j < 256; j += 64) { const float p = __expf(sc[j] - mx); sc[j] = p; sum += p; }
            sum = wave_sum(sum);
            float o = 0.f;
            for (int j = 0; j < 256; ++j) o += sc[j] * bf2f(MKV[((size_t)b * NMEM + j) * 512 + 256 + h * 64 + lane]);
            o /= sum;
            const float y = bf2f(Y[tok * DM + 768 + h * 64 + lane]);
            const float e2 = wave_sum((y - o) * (y - o)), r2 = wave_sum(o * o);
            if (lane == 0 && !(e2 <= 0.0009f * r2 + 1e-12f)) atomicAdd(F.ctl() + 49, 1u);
        }
    }
}

__device__ __forceinline__ void check_rwkv(const Frame& F) {
    constexpr int NCK = 200;
    if (F.bid >= 48) return;
    const int b = F.bid / 6, h = F.bid % 6, tid = F.tid;
    const bf16_t* P = (const bf16_t*)(F.ws + WS_P); const bf16_t* Y = (const bf16_t*)(F.ws + WS_Y); const float* mu = F.in[I_MU];
    LAS float* L = (LAS float*)F.lds;
    LAS float* xs = L;
    LAS float* vr = L + 1408, *vk = vr + 64, *vv = vk + 64, *va = vv + 64, *vb = va + 64, *vw = vb + 64, *vg = vw + 64, *vo = vg + 64, *red = vo + 64;
    float S[8];
#pragma unroll
    for (int e = 0; e < 8; ++e) S[e] = 0.f;
    const int i = tid >> 3, jg = tid & 7;
    for (int t = 0; t < NCK; ++t) {
        const size_t tok = (size_t)b * SEQ + t;
        for (int c = tid; c < 1408; c += NTHREADS) { const float cur = bf2f(P[tok * INC + C_RW + c]); const float prev = t > 0 ? bf2f(P[(tok - 1) * INC + C_RW + c]) : 0.f; xs[c] = cur + (prev - cur) * mu[c]; }
        __syncthreads();
        if (tid < 64) { const int j = tid, cj = h * 64 + j;
            float lw = 0.f, la = 0.f, lg = 0.f;
            for (int k = 0; k < 64; ++k) { lw += tanhf(xs[RW_XW + k]) * F.in[I_WUP][k * 384 + cj]; la += xs[RW_XA + k] * F.in[I_AUP][k * 384 + cj]; }
            for (int k = 0; k < 128; ++k) lg += (1.0f / (1.0f + expf(-xs[RW_XG + k]))) * F.in[I_GUP][k * 384 + cj];
            const float z = -(F.in[I_W0][cj] + lw); const float sp = z > 20.f ? z : log1pf(expf(z)); const float w = -sp - 0.5f;
            vw[j] = expf(-expf(w));
            const float a = 1.0f / (1.0f + expf(-(F.in[I_A0][cj] + la)));
            const float k0 = xs[RW_K + cj];
            vr[j] = xs[RW_R + cj]; vv[j] = xs[RW_V + cj]; vg[j] = lg;
            const float kk = k0 * F.in[I_KK][cj];
            vk[j] = k0 * (1.0f + (a - 1.0f) * F.in[I_KA][cj]);
            va[j] = kk; vb[j] = a;
        }
        __syncthreads();
        float kn_ = 0.f, a_ = 0.f;
        if (tid < 64) { float ss = 0.f; for (int j = 0; j < 64; ++j) ss += va[j] * va[j]; const float inv = 1.0f / fmaxf(sqrtf(ss), 1e-12f); kn_ = va[tid] * inv; a_ = vb[tid]; }
        __syncthreads();
        if (tid < 64) { va[tid] = -kn_; vb[tid] = kn_ * a_; }
        __syncthreads();
        float sa = 0.f;
#pragma unroll
        for (int e = 0; e < 8; ++e) sa += S[e] * va[jg * 8 + e];
        sa += __shfl_xor(sa, 1); sa += __shfl_xor(sa, 2); sa += __shfl_xor(sa, 4);
        float o = 0.f;
#pragma unroll
        for (int e = 0; e < 8; ++e) { const int j = jg * 8 + e; S[e] = S[e] * vw[j] + sa * vb[j] + vv[i] * vk[j]; o += S[e] * vr[j]; }
        o += __shfl_xor(o, 1); o += __shfl_xor(o, 2); o += __shfl_xor(o, 4);
        if (jg == 0) vo[i] = o;
        __syncthreads();
        if (tid < 64) { float m = 0.f; for (int q = 0; q < 64; ++q) m += vo[q]; m *= (1.0f / 64.0f); float var = 0.f; for (int q = 0; q < 64; ++q) var += (vo[q] - m) * (vo[q] - m); var *= (1.0f / 64.0f);
            float bon = 0.f; for (int q = 0; q < 64; ++q) bon += vr[q] * vk[q] * F.in[I_RK][h * 64 + q];
            const int cj = h * 64 + tid;
            float y = (vo[tid] - m) * rsqrtf(var + 64e-5f) * F.in[I_GNG][cj] + F.in[I_GNB][cj]; y = (y + bon * vv[tid]) * vg[tid];
            const float yk = bf2f(Y[tok * DM + 384 + cj]);
            const float e2 = wave_sum((y - yk) * (y - yk)), r2 = wave_sum(y * y);
            if (tid == 0 && !(e2 <= 0.0009f * r2 + 1e-12f)) atomicAdd(F.ctl() + 50, 1u); }
        __syncthreads();
    }
}

__device__ __forceinline__ void check_moe(const Frame& F) {
    const int tok = (F.bid * 6151 + 77) % NTOK, tid = F.tid;
    const float* X1 = F.out; LAS float* L = (LAS float*)F.lds; LAS float* xh = L, *hid = L + 1024, *lg = L + 2048, *yacc = L + 2112  ; LAS int* te = (LAS int*)(L + 3200); LAS float* tw = L + 3210;
    float ss = 0.f; for (int k = tid; k < 1024; k += NTHREADS) { const float v = X1[(size_t)tok * DM + k]; ss += v * v; }
    ss = wave_sum(ss); if (F.lane == 0) lg[40 + F.wave] = ss; __syncthreads();
    float tot = 0.f; for (int w = 0; w < 8; ++w) tot += lg[40 + w]; const float rs = rsqrtf(tot * (1.0f / DM) + 1e-5f);
    for (int k = tid; k < 1024; k += NTHREADS) { xh[k] = X1[(size_t)tok * DM + k] * rs * F.in[I_GFFN][k]; yacc[k] = 0.f; }
    __syncthreads();
    if (tid < 32) { float a = F.in[I_BR][tid]; for (int k = 0; k < 1024; ++k) a += xh[k] * F.in[I_WR][k * 32 + tid]; lg[tid] = a; }
    __syncthreads();
    if (tid == 0) { float v[4]; for (int r = 0; r < 4; ++r) { float bv = -INFINITY; int bi = 0; for (int e = 0; e < 32; ++e) if (lg[e] > bv) { bv = lg[e]; bi = e; } v[r] = bv; te[r] = bi; lg[bi] = -INFINITY; }
        float den = 0.f; for (int r = 0; r < 4; ++r) den += expf(v[r] - v[0]); for (int r = 0; r < 4; ++r) tw[r] = expf(v[r] - v[0]) / den; }
    __syncthreads();
    for (int r = 0; r < 4; ++r) { const int e = te[r]; const float* W = F.in[I_WGU] + (size_t)e * 1024 * 2048; const float* Bg = F.in[I_BGU] + (size_t)e * 2048;
        for (int j = tid; j < 1024; j += NTHREADS) { float g = Bg[2 * j], u = Bg[2 * j + 1]; for (int k = 0; k < 1024; ++k) { const f32x2 w2 = *(const f32x2*)(W + (size_t)k * 2048 + 2 * j); g += xh[k] * w2[0]; u += xh[k] * w2[1]; }
            g = fminf(g, 7.0f); u = fminf(fmaxf(u, -7.0f), 7.0f); hid[j] = (u + 1.0f) * g / (1.0f + expf(-1.702f * g)); }
        __syncthreads();
        const float* W2 = F.in[I_WDN] + (size_t)e * 1024 * 1024;
        for (int n = tid; n < 1024; n += NTHREADS) { float a = F.in[I_BDN][(size_t)e * 1024 + n]; for (int j = 0; j < 1024; ++j) a += hid[j] * W2[(size_t)j * 1024 + n]; yacc[n] += a * tw[r]; }
        __syncthreads(); }
    const bf16_t* YE = (const bf16_t*)(F.ws + WS_YE);
    float e2 = 0.f, r2 = 0.f;
    for (int n = tid; n < 1024; n += NTHREADS) { float y = 0.f; for (int k = 0; k < 4; ++k) { if (YE_ESZ == 2) y += bf2f(YE[(size_t)(tok * 4 + k) * DM + n]); else { const unsigned char q8 = ((const unsigned char*)YE)[(size_t)(tok * 4 + k) * DM + n]; y += __builtin_amdgcn_cvt_f32_fp8((unsigned)q8, 0) * (1.0f / YE_SCALE); } } e2 += (y - yacc[n]) * (y - yacc[n]); r2 += yacc[n] * yacc[n]; }
    e2 = wave_sum(e2); r2 = wave_sum(r2); if (F.lane == 0) { lg[48 + F.wave] = e2; lg[56 + F.wave] = r2; } __syncthreads();
    if (tid == 0) { float a = 0.f, c = 0.f; for (int w = 0; w < 8; ++w) { a += lg[48 + w]; c += lg[56 + w]; } if (!(a <= (MOE_FP8 ? 0.0225f : 0.0009f) * c + 1e-12f)) atomicAdd(F.ctl() + 51, 1u); }
    __syncthreads();
}
#endif
__global__ void __launch_bounds__(NTHREADS, 2) hymba_fwd(Params prm) {
    extern __shared__ __attribute__((aligned(16))) unsigned char lds_raw[];
    cg::grid_group grid = cg::this_grid();
    Frame F; F.lds = (LAS unsigned char*)lds_raw; F.tid = threadIdx.x; F.lane = F.tid & 63; F.wave = __builtin_amdgcn_readfirstlane(F.tid >> 6); F.G = gridDim.x; F.bid = blockIdx.x;
    F.in = prm.in; F.out = prm.out; F.ws = prm.ws;
    unsigned char* ws = prm.ws;
    volatile LAS unsigned* bar_st = (volatile LAS unsigned*)(F.lds + LDS_BYTES - 16);
    if (threadIdx.x == 0) { bar_st[0] = 0u; bar_st[1] = 0u; }
    unsigned* bar_words = (unsigned*)(ws + WS_CTL + 65536);
    if (F.bid == 0) for (int i = threadIdx.x; i < XCD_BAR_WORDS; i += NTHREADS) bar_words[i] = 0u;
#if defined(PROBE_I)
#define STAMP(k) do { if (F.bid == 0 && threadIdx.x == 0) ((unsigned long long*)(ws + WS_CTL + 4096))[k] = __builtin_amdgcn_s_memrealtime(); } while (0)
#else
#define STAMP(k) do {} while (0)
#endif
#ifndef NGEMM
#define NGEMM 144
#endif
#ifndef CONV_X
#define CONV_X 12288
#endif
#ifndef DOUBLE_PHASE
#define DOUBLE_PHASE -1
#endif
#define REP(k) for (int rep_ = 0; rep_ < ((DOUBLE_PHASE == (k)) ? 2 : 1); ++rep_)
#define RELAUNDER() do { int t_ = threadIdx.x; asm volatile("" : "+v"(t_)); F.tid = t_; F.lane = t_ & 63; } while (0)
#if defined(TIMING_SCAFFOLD)
#define EXIT_AFTER(k) do { if (prm.phase_hi <= (k)) return; } while (0)
#else
#define EXIT_AFTER(k) do {} while (0)
#endif
#ifndef NPASS
#define NPASS 1
#endif
    XcdBarrier xbar; xbar.bar = bar_words; xbar.x = 0; xbar.st = bar_st;
#pragma unroll 1
    for (int pass_ = 0; pass_ < NPASS; ++pass_) {
#if defined(TIMING_SCAFFOLD)
    if (prm.phase_hi < 0) {
        const int m = -prm.phase_hi;
        if (m <= 2) exp_stream_read(F, m);
        else if (m == 3) { if (F.bid < NGEMM) { pg8::StaticOrder S; S.init(NTOK, INC, NGEMM, F.bid); EpiRowScaleBf16 E{(bf16_t*)(ws + WS_P), INC, (const float*)(ws + WS_RS1)};
              pg8::gemm_phase<false, 2>(F.lds, (const bf16_t*)(ws + WS_XB), (const bf16_t*)(ws + WS_WIN), DM, S, E); } }
        else if (m == 4) { if (F.bid >= NGEMM) moe_weight_conversion(F, F.bid - NGEMM, F.G - NGEMM, MOE_TT); }
        else if (m == 5) { moe_weight_conversion(F, F.bid, F.G, MOE_TT); }
        else if (m == 7 || m == 8 || m == 9) { if (F.bid == 0 && F.tid < 64) F.ctl()[F.tid] = 0u; grid.sync();
            if (m == 7) attention_phase(F, 32); else if (m == 8) { if (F.bid < NB * 6) rwkv_scan(F, F.bid / 6, F.bid % 6); } else rwkv_chunk_phase(F); }
        else if (m == 6) { pg8::StaticOrder S; S.init(NTOK, INC, F.G, F.bid); EpiRowScaleBf16 E{(bf16_t*)(ws + WS_P), INC, (const float*)(ws + WS_RS1)};
              pg8::gemm_phase<false, 2>(F.lds, (const bf16_t*)(ws + WS_XB), (const bf16_t*)(ws + WS_WIN), DM, S, E); }
        return; }
#endif
    EXIT_AFTER(0);
    if (pass_ > 0) xcd_barrier(xbar);
    STAMP(0);
    REP(0) p0_prologue(F);
    grid.sync(); RELAUNDER(); STAMP(1); EXIT_AFTER(1);
    if (pass_ == 0) xbar = xcd_barrier_post(bar_words, bar_st);
    REP(1) {
    if (F.bid < NGEMM) {
        Frame F2 = F; F2.G = NGEMM;
        kmean_task(F2);
        { pg8::StaticOrder S; S.init(NTOK, INC, NGEMM, F.bid); EpiRowScaleBf16 E{(bf16_t*)(ws + WS_P), INC, (const float*)(ws + WS_RS1)};
          pg8::gemm_phase<false, 2>(F.lds, (const bf16_t*)(ws + WS_XB), (const bf16_t*)(ws + WS_WIN), DM, S, E); }
        { pg8::StaticOrder S; S.init(NB * NMEM, 512, NGEMM, F.bid); EpiRowScaleBf16 E{(bf16_t*)(ws + WS_MKV), 512, (const float*)(ws + WS_RS1 + 65536)};
          pg8::gemm_phase<false, 2>(F.lds, (const bf16_t*)(ws + WS_MEMB), (const bf16_t*)(ws + WS_WMKV), DM, S, E); }
    }
    moe_weight_conversion(F, F.bid >= NGEMM ? F.bid - NGEMM : -1, F.G - NGEMM, CONV_X);
    }
    xcd_barrier(xbar); RELAUNDER(); STAMP(2); EXIT_AFTER(2);
#ifndef CHUNK_CUT
#define CHUNK_CUT 7
#endif
    rwkv_chunk_phase(F);
    if (DOUBLE_PHASE == 2) { __syncthreads(); rwkv_chunk_phase<CHUNK_CUT>(F); }
    xcd_barrier(xbar); RELAUNDER(); STAMP(3); EXIT_AFTER(3);
    REP(3) { if (F.bid < NB * 6) rwkv_scan(F, F.bid / 6, F.bid % 6);
    RELAUNDER();
    attention_phase(F, 32 + rep_); }
    xcd_barrier(xbar); RELAUNDER(); STAMP(4); EXIT_AFTER(4);
#if defined(SELFCHECK)
    check_attention(F); __syncthreads(); check_rwkv(F); __syncthreads();
#endif
    REP(4) { pg8::StaticOrder S; S.init(NTOK, DM, F.G, F.bid); EpiResidual E{F.in[I_X], F.out, ws + WS_X1B};
      pg8::gemm_phase<false, 2>(F.lds, (const bf16_t*)(ws + WS_Y), (const bf16_t*)(ws + WS_WOUT), DM, S, E); }
    xcd_barrier(xbar); RELAUNDER(); STAMP(5); EXIT_AFTER(5);
    if (DOUBLE_PHASE == 7) { router_phase(F, true); __syncthreads(); }
    router_phase(F);
    xcd_barrier(xbar); RELAUNDER(); STAMP(6); EXIT_AFTER(6);
    REP(5) { const UTab T = build_unit_table(F, 8); pg8::TableOrder S{T.meta, T.rows, T.nunits, 0};
      EpiSwiglu E{T.meta, T.rows, (const float*)(ws + WS_RS1 + 131072), F.in[I_BGU], ws + WS_HMID};
      pg8::gemm_phase<true, MOE_ESZ>(F.lds, ws + WS_X1B, ws + WS_WGU, DM, S, E); }
    xcd_barrier(xbar); RELAUNDER(); STAMP(7); EXIT_AFTER(7);
    REP(6) { const UTab T = build_unit_table(F, 4); pg8::TableOrder S{T.meta, T.rows, T.nunits, 1};
      EpiDown E{T.meta, T.rows, (const float*)(ws + WS_TOPW), F.in[I_BDN], ws + WS_YE};
      pg8::gemm_phase<true, MOE_ESZ>(F.lds, ws + WS_HMID, ws + WS_WDN, DM, S, E); }
    xcd_barrier(xbar); RELAUNDER(); STAMP(8); EXIT_AFTER(8);
#if defined(SELFCHECK)
    check_moe(F); grid.sync();
#endif
    if (DOUBLE_PHASE == 8) { final_phase(F, true); grid.sync(); }
    if (DOUBLE_PHASE == 9) { for (int q = 0; q < 8; ++q) grid.sync(); }
    final_phase(F);
    }
#if defined(PROBE_I)
    STAMP(9);
    xcd_barrier(xbar);
    { const unsigned long long* ts = (const unsigned long long*)(ws + WS_CTL + 4096);
      const int pa[11] = {0, 1, 2, 3, 4, 5, 6, 7, 8, 3, 0}, pb[11] = {1, 2, 3, 4, 5, 6, 7, 8, 9, 10, 9};
      const float di = (float)(ts[pb[PROBE_I]] - ts[pa[PROBE_I]]) * 0.01f, dj = (float)(ts[pb[PROBE_J]] - ts[pa[PROBE_J]]) * 0.01f;
      const float ni = floorf((di + PROBE_OFF) * (1.0f / PROBE_BIN)), nj = floorf((dj + PROBE_OFF) * (1.0f / PROBE_BIN));
      const float sc = 1.0f + 0.1f * ni;
      for (size_t i = (size_t)F.bid * NTHREADS + F.tid; i < (size_t)NTOK * DM; i += (size_t)F.G * NTHREADS) F.out[i] = F.out[i] * sc + (i == 0 ? 50.0f * nj : 0.f); }
#endif
    if (xb_ld(&bar_words[XB_TMO]) != 0u) { for (size_t i = (size_t)F.bid * NTHREADS + F.tid; i < (size_t)NTOK * DM; i += (size_t)F.G * NTHREADS) F.out[i] = __builtin_nanf(""); }
#if defined(SELFCHECK)
    { const unsigned* c = F.ctl(); const unsigned mask = (c[48] > 40u ? 1u : 0u) | (c[49] > 2u ? 2u : 0u) | (c[50] > 2u ? 4u : 0u) | (c[51] > 0u ? 8u : 0u);
      if (mask) { grid.sync(); const float sc = 1.0f + 0.1f * (float)mask; for (size_t i = (size_t)F.bid * NTHREADS + F.tid; i < (size_t)NTOK * DM; i += (size_t)F.G * NTHREADS) F.out[i] *= sc; } }
#endif
}

extern "C" void kernel_launch(void* const* d_in, const int* in_sizes, int n_in, void* d_out, int out_size, void* d_ws, size_t ws_size, hipStream_t stream) {
    static int grid = 0;
    if (grid == 0) {
        if (n_in != 27 || out_size != NTOK * DM || ws_size < WS_END) { fprintf(stderr, "kernel_launch: unexpected problem (n_in %d, out %d, ws %zu)\n", n_in, out_size, ws_size); grid = -1; return; }
        int dev = 0, cus = 0, per_cu = 0;
        hipGetDevice(&dev); hipDeviceGetAttribute(&cus, hipDeviceAttributeMultiprocessorCount, dev);
        if (hipFuncSetAttribute((const void*)hymba_fwd, hipFuncAttributeMaxDynamicSharedMemorySize, LDS_BYTES) != hipSuccess) { fprintf(stderr, "kernel_launch: hipFuncSetAttribute failed\n"); }
        if (hipOccupancyMaxActiveBlocksPerMultiprocessor(&per_cu, (const void*)hymba_fwd, NTHREADS, LDS_BYTES) != hipSuccess || per_cu < 1) { fprintf(stderr, "kernel_launch: occupancy query says %d\n", per_cu); per_cu = 1; }
        (void)hipGetLastError();
        grid = cus;
        fprintf(stderr, "kernel_launch: grid %d (per_cu %d)\n", grid, per_cu);
    }
    if (grid < 0) return;
    Params p{};
    for (int i = 0; i < 27; ++i) p.in[i] = (const float*)d_in[i];
    p.out = (float*)d_out; p.ws = (unsigned char*)d_ws; p.phase_hi = 99;
#if defined(PARTIAL_K)
    { Params q = p; q.phase_hi = PARTIAL_K; void* qa[] = {&q}; (void)hipLaunchCooperativeKernel((const void*)hymba_fwd, dim3(grid), dim3(NTHREADS), qa, LDS_BYTES, stream); }
#endif
    void* args[] = {&p};
    hipError_t e = hipLaunchCooperativeKernel((const void*)hymba_fwd, dim3(grid), dim3(NTHREADS), args, LDS_BYTES, stream);
    if (e != hipSuccess) fprintf(stderr, "kernel_launch: cooperative launch failed: %s (grid %d)\n", hipGetErrorString(e), grid);
#if defined(TWICE)
    e = hipLaunchCooperativeKernel((const void*)hymba_fwd, dim3(grid), dim3(NTHREADS), args, LDS_BYTES, stream);
#endif
}
```

```cpp
#include <hip/hip_runtime.h>
#include <hip/hip_cooperative_groups.h>
#include <cstdio>
#include <cstdint>
namespace cg = cooperative_groups;

#define LAS __attribute__((address_space(3)))
typedef unsigned short bf16_t;
typedef short bf16x8 __attribute__((ext_vector_type(8)));
typedef short s16x4 __attribute__((ext_vector_type(4)));
typedef float f32x2 __attribute__((ext_vector_type(2)));
typedef float f32x4 __attribute__((ext_vector_type(4)));
typedef float f32x16 __attribute__((ext_vector_type(16)));
typedef unsigned u32x2 __attribute__((ext_vector_type(2)));
typedef unsigned u32x4 __attribute__((ext_vector_type(4)));

constexpr int NB = 8, SEQ = 2048, DM = 1024, NTOK = NB * SEQ;
constexpr int INC = 2816;
constexpr int C_Q = 0, C_K = 384, C_V = 768, C_RW = 1152, C_MQ = 2560;
constexpr int RW_R = 0, RW_K = 384, RW_V = 768, RW_XW = 1152, RW_XA = 1216, RW_XG = 1280;
constexpr int NMEM = 256, NEXP = 32, TOPK = 4, NASSIGN = NTOK * TOPK;
constexpr int DUMMY_ROW = NASSIGN;
constexpr int NTHREADS = 512;

#ifndef MOE_FP8
#define MOE_FP8 1
#endif
constexpr int MOE_ESZ = MOE_FP8 ? 1 : 2;
#ifndef YE_FP8
#define YE_FP8 MOE_FP8
#endif
constexpr int YE_ESZ = YE_FP8 ? 1 : 2; constexpr float YE_SCALE = YE_FP8 ? 16.0f : 1.0f;
constexpr size_t MiB = 1u << 20;
constexpr size_t WS_CTL = 0;
constexpr size_t WS_WIN = 1 * MiB;
constexpr size_t WS_WOUT = 7 * MiB;
constexpr size_t WS_WMKV = 9 * MiB;
constexpr size_t WS_LORA = 10 * MiB;
constexpr size_t WS_RS1 = 11 * MiB;
constexpr size_t WS_XPART = 12 * MiB;
constexpr size_t WS_KM = 13 * MiB;
constexpr size_t WS_TOPW = 14 * MiB;
constexpr size_t WS_LIST = 15 * MiB;
constexpr size_t WS_MEMB = 17 * MiB;
constexpr size_t WS_MKV = 21 * MiB;
constexpr size_t WS_XB = 24 * MiB;
constexpr size_t WS_P = 56 * MiB;
constexpr size_t WS_Y = 144 * MiB;
constexpr size_t WS_X1B = 176 * MiB;
constexpr size_t WS_WGU = 208 * MiB;
constexpr size_t WS_WDN = 336 * MiB;
constexpr size_t WS_HMID = 400 * MiB;
constexpr size_t WS_YE = 530 * MiB;
constexpr size_t WS_RW = 660 * MiB;
constexpr size_t WS_END = 760 * MiB;

constexpr int RING_BYTES = 131072;
constexpr int XTRA_OFF = RING_BYTES;
constexpr int LDS_BYTES = 152 * 1024;

__device__ __forceinline__ unsigned f2bf(float f) { unsigned u = __builtin_bit_cast(unsigned, f); return (u + 0x7fffu + ((u >> 16) & 1u)) >> 16; }
typedef __bf16 bf16x2_hw __attribute__((ext_vector_type(2)));
__device__ __forceinline__ unsigned pk2(float lo, float hi) { const f32x2 v = {lo, hi}; return __builtin_bit_cast(unsigned, __builtin_convertvector(v, bf16x2_hw)); }
__device__ __forceinline__ unsigned pk4_fp8(float a, float b, float c, float d) { unsigned r = 0; r = __builtin_amdgcn_cvt_pk_fp8_f32(a, b, r, false); r = __builtin_amdgcn_cvt_pk_fp8_f32(c, d, r, true); return r; }
__device__ __forceinline__ float bf2f(unsigned short h) { return __builtin_bit_cast(float, (unsigned)h << 16); }
__device__ __forceinline__ float bflo(unsigned w) { return __builtin_bit_cast(float, w << 16); }
__device__ __forceinline__ float bfhi(unsigned w) { return __builtin_bit_cast(float, w & 0xffff0000u); }
__device__ __forceinline__ float wave_sum(float v) {
#pragma unroll
    for (int o = 32; o >= 1; o >>= 1) v += __shfl_xor(v, o);
    return v;
}

struct Params { const float* in[27]; float* out; unsigned char* ws; int phase_hi; int pad; };
enum { I_X = 0, I_MEM, I_WIN, I_WOUT, I_WMKV, I_GMIX, I_GMEM, I_GFFN, I_GFIN, I_RELB, I_MU, I_W0, I_WUP, I_A0, I_AUP, I_GUP, I_KK, I_KA, I_RK, I_GNG, I_GNB, I_WR, I_BR, I_WGU, I_BGU, I_WDN, I_BDN };

namespace pg8 {
constexpr int W8_SHIFT = 5;
constexpr int BM = 256, BK = 64, HALF = 128, HTB = HALF * BK * 2, NXCD = 8, WGM = 8;
__host__ __device__ __forceinline__ int lds_byte(int r, int c) { const int st = (r >> 4) * 2 + (c >> 5), rr = r & 15, cc = c & 31, ob = rr * 64 + cc * 2; return st * 1024 + (ob ^ (((ob >> 9) & 1) << 5)); }
__host__ __device__ __forceinline__ void stage_rc(int b, int& R, int& C) { const int st = b / 1024, sb = b % 1024, swz = sb ^ (((sb >> 9) & 1) << 5); R = (st >> 1) * 16 + swz / 64; C = (st & 1) * 32 + (swz % 64) / 2; }
__host__ __device__ __forceinline__ int perm32(int rho) { const int n = rho >> 4, i = rho & 15; return 8 * (i >> 2) + 4 * n + (i & 3); }

struct Unit { int pm, pn, ti; };

__device__ __forceinline__ int xcd_remap(int L, int nwg) { const int q = nwg / NXCD, r = nwg % NXCD, xcd = L % NXCD, off = L / NXCD; return (xcd < r ? xcd * (q + 1) : r * (q + 1) + (xcd - r) * q) + off; }

struct StaticOrder {
    int nM, nN, nwg, G, c;
    __device__ void init(int M, int N, int G_, int c_) { nM = M / BM; nN = N / BM; nwg = nM * nN; G = G_; c = c_; }
    __device__ bool next(int i, Unit& u) const {
        const long L = (long)i * G + c; if (L >= nwg) return false;
        const int wgid = xcd_remap((int)L, nwg);
        const int nig = WGM * nN, gid = wgid / nig, fm = gid * WGM, gsz = (nM - fm) < WGM ? (nM - fm) : WGM;
        u.pm = fm + ((wgid % nig) % gsz); u.pn = (wgid % nig) / gsz; u.ti = 0; return true;
    }
    __device__ __forceinline__ int srcrow(const Unit&, int) const { return 0; }
};

struct TableOrder {
    const LAS int* meta;
    const LAS int* rows;
    int nunits; int mode;
    __device__ bool next(int i, Unit& u) const { if (i >= nunits) return false; u.pm = 0; u.pn = __builtin_amdgcn_readfirstlane(meta[i * 4]); u.ti = i; return true; }
    __device__ __forceinline__ int srcrow(const Unit& u, int r) const { const int a = rows[u.ti * 256 + r]; return mode == 0 ? (a < 0 ? 0 : (a >> 2)) : (a < 0 ? DUMMY_ROW : a); }
};

__device__ __forceinline__ unsigned cvt_pk_bf16(float lo, float hi) { unsigned r; asm volatile("v_cvt_pk_bf16_f32 %0, %1, %2" : "=v"(r) : "v"(lo), "v"(hi)); return r; }

typedef int i32x8 __attribute__((ext_vector_type(8)));
template <bool GATHER, int ESZ, class Epi, class Sched>
__device__ __forceinline__ void gemm_phase(LAS unsigned char* lds, const void* A, const void* Bt, const int K, const Sched& S, const Epi& E) {
    int tid = threadIdx.x; asm volatile("" : "+v"(tid));
    const int wid = __builtin_amdgcn_readfirstlane(tid >> 6), lane = tid & 63, wr = wid >> 2, wc = wid & 3, fr = lane & 15, fq = lane >> 4;
    const int nt = K * ESZ / (BK * 2);
    unsigned voffB[2]; int RA[2], CA[2];
#pragma unroll
    for (int i = 0; i < 2; ++i) { int R, C; stage_rc(tid * 16 + i * 8192, R, C); const int Rb = (R & ~31) + perm32(R & 31);
        RA[i] = R; CA[i] = C; voffB[i] = (unsigned)(Rb * K * ESZ + C * 2); }
    const int kstep = BK * 2;
    const int hstep = HALF * K * ESZ;
    const int tstep = 2 * hstep;
    const __amdgpu_buffer_rsrc_t rA = __builtin_amdgcn_make_buffer_rsrc((void*)A, 0, -1, 0x00020000), rB = __builtin_amdgcn_make_buffer_rsrc((void*)Bt, 0, -1, 0x00020000);
    const unsigned ldsw = (unsigned)wid * 1024u;
    const int aoff = lds_byte(wr * 64 + fr, fq * 8), boff = lds_byte(wc * 32 + fr, fq * 8);
    unsigned vC[2][2], vN[2][2];
#define PG8_SA(b, h) (((b) * 2 + (h)) * HTB)
#define PG8_SB(b, h) ((4 + (b) * 2 + (h)) * HTB)
#define PG8_STAGE(bufoff, rsrc, soff, voff) do { _Pragma("unroll") for (int _i = 0; _i < 2; ++_i) \
        __builtin_amdgcn_raw_ptr_buffer_load_lds(rsrc, (LAS void*)(lds + (bufoff) + ldsw + _i * 8192), 16, (int)(voff)[_i], (int)(soff), 0, 0); } while (0)
#define PG8_LDA(dst, b, h) do { _Pragma("unroll") for (int m = 0; m < 4; ++m) { \
        if constexpr (ESZ == 2) { _Pragma("unroll") for (int k = 0; k < 2; ++k) dst[m][k] = *(const LAS bf16x8*)(lds + PG8_SA(b, h) + aoff + m * 2048 + k * 1024); } \
        else { const u32x4 lo_ = *(const LAS u32x4*)(lds + PG8_SA(b, h) + aoff + m * 2048), hi_ = *(const LAS u32x4*)(lds + PG8_SA(b, h) + aoff + m * 2048 + 1024); \
               dst##8[m] = (i32x8){(int)lo_.x, (int)lo_.y, (int)lo_.z, (int)lo_.w, (int)hi_.x, (int)hi_.y, (int)hi_.z, (int)hi_.w}; } } } while (0)
#define PG8_LDB(dst, b, h) do { _Pragma("unroll") for (int n = 0; n < 2; ++n) { \
        if constexpr (ESZ == 2) { _Pragma("unroll") for (int k = 0; k < 2; ++k) dst[n][k] = *(const LAS bf16x8*)(lds + PG8_SB(b, h) + boff + n * 2048 + k * 1024); } \
        else { const u32x4 lo_ = *(const LAS u32x4*)(lds + PG8_SB(b, h) + boff + n * 2048), hi_ = *(const LAS u32x4*)(lds + PG8_SB(b, h) + boff + n * 2048 + 1024); \
               dst##8[n] = (i32x8){(int)lo_.x, (int)lo_.y, (int)lo_.z, (int)lo_.w, (int)hi_.x, (int)hi_.y, (int)hi_.z, (int)hi_.w}; } } } while (0)
#define PG8_MMA(ai, bj, At, Bt_) do { __builtin_amdgcn_s_setprio(1); _Pragma("unroll") for (int m = 0; m < 4; ++m) _Pragma("unroll") for (int n = 0; n < 2; ++n) { \
        if constexpr (ESZ == 2) { _Pragma("unroll") for (int k = 0; k < 2; ++k) acc[ai][bj][m][n] = __builtin_amdgcn_mfma_f32_16x16x32_bf16(Bt_[n][k], At[m][k], acc[ai][bj][m][n], 0, 0, 0); } \
        else asm volatile("v_mfma_scale_f32_16x16x128_f8f6f4 %0, %1, %2, %0, %3, %4 op_sel_hi:[0,0,0]" : "+v"(acc[ai][bj][m][n]) : "v"(Bt_##8[n]), "v"(At##8[m]), "v"(scw_), "v"(sca_)); } \
        __builtin_amdgcn_s_setprio(0); } while (0)
#define PG8_WAIT_V(n) asm volatile("s_waitcnt vmcnt(" #n ")" ::: "memory")
#define PG8_WAIT_L(n) asm volatile("s_waitcnt lgkmcnt(" #n ")" ::: "memory")
#define PG8_BAR __builtin_amdgcn_s_barrier()
#define PG8_SCHED __builtin_amdgcn_sched_barrier(0)
#define PG8_SETV(dst, u) do { _Pragma("unroll") for (int _h = 0; _h < 2; ++_h) _Pragma("unroll") for (int _i = 0; _i < 2; ++_i) \
        dst[_h][_i] = GATHER ? (unsigned)(S.srcrow(u, _h * HALF + RA[_i]) * K * ESZ + CA[_i] * 2) : (unsigned)((_h * HALF + RA[_i]) * K * ESZ + CA[_i] * 2); } while (0)
    Unit cur, nxt; int ui = 0;
    if (!S.next(0, cur)) return;
    f32x4 acc[2][2][4][2];
#pragma unroll
    for (int a = 0; a < 2; ++a)
#pragma unroll
        for (int b = 0; b < 2; ++b)
#pragma unroll
            for (int m = 0; m < 4; ++m)
#pragma unroll
                for (int n = 0; n < 2; ++n) acc[a][b][m][n] = (f32x4){0.f, 0.f, 0.f, 0.f};
    const int scw_ = 127 - W8_SHIFT, sca_ = 127;
    bf16x8 At[4][2], B0[2][2], B1[2][2]; i32x8 At8[4], B08[2], B18[2];
    int cA = GATHER ? 0 : cur.pm * tstep, cB = cur.pn * tstep;
    PG8_SETV(vC, cur);
    if (GATHER) PG8_WAIT_L(0);
    PG8_STAGE(PG8_SB(0, 0), rB, cB, voffB); PG8_STAGE(PG8_SB(0, 1), rB, cB + hstep, voffB); PG8_STAGE(PG8_SA(0, 0), rA, cA, vC[0]); PG8_STAGE(PG8_SA(0, 1), rA, cA, vC[1]);
    if (wr == 1) PG8_BAR;
    PG8_WAIT_V(2); PG8_BAR;
    PG8_STAGE(PG8_SB(1, 0), rB, cB + kstep, voffB); PG8_STAGE(PG8_SA(1, 0), rA, cA + kstep, vC[0]); PG8_STAGE(PG8_SB(1, 1), rB, cB + hstep + kstep, voffB);
    PG8_WAIT_V(6); PG8_BAR;
    for (;;) {
        const bool has_next = S.next(ui + 1, nxt);
        float pre_[24]; E.pre(pre_, cur, wr, wc, fr, fq);
        const int nA = GATHER ? 0 : (has_next ? nxt.pm * tstep : cA), nB = has_next ? nxt.pn * tstep : cB;
        if (GATHER) { if (has_next) { PG8_SETV(vN, nxt); } else {
#pragma unroll
            for (int h = 0; h < 2; ++h)
#pragma unroll
                for (int i = 0; i < 2; ++i) vN[h][i] = vC[h][i]; } }
#pragma unroll 1
        for (int t = 0; t < nt; t += 2) {
            const bool last = (t == nt - 2);
            const int a1 = cA + (t + 1) * kstep;
            const int a2 = last ? nA : cA + (t + 2) * kstep, b2 = last ? nB : cB + (t + 2) * kstep;
            const int a3 = a2 + kstep, b3 = b2 + kstep;
            unsigned v2[2][2];
#pragma unroll
            for (int h = 0; h < 2; ++h)
#pragma unroll
                for (int i = 0; i < 2; ++i) v2[h][i] = (GATHER && last) ? vN[h][i] : vC[h][i];
            PG8_LDB(B0, 0, 0); PG8_LDB(B1, 0, 1); PG8_SCHED; PG8_LDA(At, 0, 0); PG8_STAGE(PG8_SA(1, 1), rA, a1, vC[1]);
            PG8_WAIT_V(8); PG8_WAIT_L(0); PG8_BAR; PG8_MMA(0, 0, At, B0); PG8_MMA(0, 1, At, B1); PG8_BAR; PG8_SCHED;
            PG8_LDA(At, 0, 1); PG8_STAGE(PG8_SB(0, 0), rB, b2, voffB); PG8_STAGE(PG8_SB(0, 1), rB, b2 + hstep, voffB); PG8_STAGE(PG8_SA(0, 0), rA, a2, v2[0]);
            PG8_WAIT_V(8); PG8_WAIT_L(0); PG8_BAR; PG8_MMA(1, 0, At, B0); PG8_MMA(1, 1, At, B1); PG8_BAR; PG8_SCHED;
            PG8_LDB(B0, 1, 0); PG8_LDB(B1, 1, 1); PG8_SCHED; PG8_LDA(At, 1, 0); PG8_STAGE(PG8_SA(0, 1), rA, a2, v2[1]);
            PG8_WAIT_V(8); PG8_WAIT_L(0); PG8_BAR; PG8_MMA(0, 0, At, B0); PG8_MMA(0, 1, At, B1); PG8_BAR; PG8_SCHED;
            PG8_LDA(At, 1, 1); PG8_STAGE(PG8_SB(1, 0), rB, b3, voffB); PG8_STAGE(PG8_SB(1, 1), rB, b3 + hstep, voffB); PG8_STAGE(PG8_SA(1, 0), rA, a3, v2[0]);
            PG8_WAIT_V(8); PG8_WAIT_L(0); PG8_BAR; PG8_MMA(1, 0, At, B0); PG8_MMA(1, 1, At, B1); PG8_BAR; PG8_SCHED;
        }
        if (wr == 0) PG8_BAR;
        if constexpr (ESZ == 1) asm volatile("s_nop 15\n\ts_nop 7" ::: "memory");
        { int l2_ = lane; asm volatile("" : "+v"(l2_));
          E(acc, cur, wr, wc, l2_ & 15, l2_ >> 4, pre_); }
        if (!has_next) break;
#pragma unroll
        for (int a = 0; a < 2; ++a)
#pragma unroll
            for (int b = 0; b < 2; ++b)
#pragma unroll
                for (int m = 0; m < 4; ++m)
#pragma unroll
                    for (int n = 0; n < 2; ++n) acc[a][b][m][n] = (f32x4){0.f, 0.f, 0.f, 0.f};
        cur = nxt; cA = nA; cB = nB; ++ui;
#pragma unroll
        for (int h = 0; h < 2; ++h)
#pragma unroll
            for (int i = 0; i < 2; ++i) vC[h][i] = vN[h][i];
        if (wr == 1) PG8_BAR;
    }
    PG8_WAIT_V(0);
    PG8_BAR;
#undef PG8_SA
#undef PG8_SB
#undef PG8_STAGE
#undef PG8_LDA
#undef PG8_LDB
#undef PG8_MMA
#undef PG8_WAIT_V
#undef PG8_WAIT_L
#undef PG8_BAR
#undef PG8_SCHED
#undef PG8_SETV
}
}
#define XB_TMO      128
#define XB_XCNT(j)  (256  + 64 * (j))
#define XB_XSUB(j)  (1280 + 64 * (j))
#define XB_XGEN(j)  (2304 + 64 * (j))
#define XB_TOP      3328
#define XB_TOPGEN   3392
#define XCD_BAR_WORDS 3456
#define XB_SPIN_CAP (1u << 18)
__device__ __forceinline__ unsigned xb_ld(unsigned* p)              { return __hip_atomic_load(p, __ATOMIC_RELAXED, __HIP_MEMORY_SCOPE_AGENT); }
__device__ __forceinline__ unsigned xb_add(unsigned* p, unsigned v) { return __hip_atomic_fetch_add(p, v, __ATOMIC_RELAXED, __HIP_MEMORY_SCOPE_AGENT); }
__device__ __forceinline__ unsigned xb_xcc_id() { return (unsigned)__builtin_amdgcn_s_getreg((3 << 11) | 20) & 0xFu; }
#define XB_SPIN(cond, bar) do { unsigned _sp = 0; while (cond) { __builtin_amdgcn_s_sleep(1); \
    if ((++_sp & 255u) == 0u) { if (xb_ld(&(bar)[XB_TMO])) break; if (_sp > XB_SPIN_CAP) { atomicAdd(&(bar)[XB_TMO], 1u); break; } } } } while (0)
struct XcdBarrier { unsigned* bar; unsigned x; volatile LAS unsigned* st; };
__device__ __forceinline__ XcdBarrier xcd_barrier_post(unsigned* bar, volatile LAS unsigned* st) {
    XcdBarrier b; b.bar = bar; b.x = xb_xcc_id(); b.st = st;
    if (threadIdx.x == 0) (void)xb_add(&bar[XB_XCNT(b.x)], 1u);
    return b;
}
__device__ __forceinline__ void xcd_barrier_complete(unsigned* bar, unsigned x, unsigned& nloc, unsigned& nx) {
    const unsigned G = gridDim.x * gridDim.y * gridDim.z;
    unsigned sum, cnt, mine, sp = 0u;
    for (;;) {
        sum = 0u; cnt = 0u; mine = 0u;
#pragma unroll
        for (unsigned j = 0; j < 16; ++j) { const unsigned c = xb_ld(&bar[XB_XCNT(j)]); sum += c; cnt += (c > 0u) ? 1u : 0u; mine = (j == x) ? c : mine; }
        if (sum == G) break;
        __builtin_amdgcn_s_sleep(1);
        if ((++sp & 255u) == 0u) { if (xb_ld(&bar[XB_TMO])) break; if (sp > XB_SPIN_CAP) { atomicAdd(&bar[XB_TMO], 1u); break; } }
    }
    nloc = mine > 0u ? mine : 1u; nx = cnt > 0u ? cnt : 1u;
}
__device__ __forceinline__ void xcd_barrier(const XcdBarrier& b) {
    asm volatile("s_waitcnt vmcnt(0)" ::: "memory");
    __syncthreads();
    if (threadIdx.x == 0) {
        unsigned* bar = b.bar;
        __builtin_amdgcn_s_waitcnt(0);
        unsigned nloc = b.st[0], nx = b.st[1];
        if (nloc == 0u) { xcd_barrier_complete(bar, b.x, nloc, nx); b.st[0] = nloc; b.st[1] = nx; }
        const unsigned old = xb_add(&bar[XB_XSUB(b.x)], 1u);
        const unsigned gen = old / nloc;
        if (old + 1u == (gen + 1u) * nloc) {
            __builtin_amdgcn_fence(__ATOMIC_RELEASE, "agent");
            asm volatile("s_waitcnt vmcnt(0)" ::: "memory");
            const unsigned og = xb_add(&bar[XB_TOP], 1u);
            const unsigned tg = og / nx;
            if (og + 1u == (tg + 1u) * nx) xb_add(&bar[XB_TOPGEN], 1u);
            else XB_SPIN(xb_ld(&bar[XB_TOPGEN]) == tg, bar);
            __builtin_amdgcn_fence(__ATOMIC_ACQUIRE, "agent");
            xb_add(&bar[XB_XGEN(b.x)], 1u);
            asm volatile("s_waitcnt vmcnt(0)" ::: "memory");
        } else {
            XB_SPIN(xb_ld(&bar[XB_XGEN(b.x)]) == gen, bar);
            __builtin_amdgcn_fence(__ATOMIC_ACQUIRE, "agent");
            asm volatile("s_waitcnt vmcnt(0)" ::: "memory");
        }
    }
    __syncthreads();
}

__device__ __forceinline__ unsigned xcd_barrier_arrive(const XcdBarrier& b) {
    asm volatile("s_waitcnt vmcnt(0)" ::: "memory");
    __syncthreads();
    unsigned tok = 0u;
    if (threadIdx.x == 0) {
        unsigned* bar = b.bar;
        __builtin_amdgcn_s_waitcnt(0);
        unsigned nloc = b.st[0], nx = b.st[1];
        if (nloc == 0u) { xcd_barrier_complete(bar, b.x, nloc, nx); b.st[0] = nloc; b.st[1] = nx; }
        const unsigned old = xb_add(&bar[XB_XSUB(b.x)], 1u);
        const unsigned gen = old / nloc;
        if (old + 1u == (gen + 1u) * nloc) {
            __builtin_amdgcn_fence(__ATOMIC_RELEASE, "agent");
            asm volatile("s_waitcnt vmcnt(0)" ::: "memory");
            const unsigned og = xb_add(&bar[XB_TOP], 1u);
            const unsigned tg = og / nx;
            if (og + 1u == (tg + 1u) * nx) xb_add(&bar[XB_TOPGEN], 1u);
            else XB_SPIN(xb_ld(&bar[XB_TOPGEN]) == tg, bar);
            __builtin_amdgcn_fence(__ATOMIC_ACQUIRE, "agent");
            xb_add(&bar[XB_XGEN(b.x)], 1u);
            asm volatile("s_waitcnt vmcnt(0)" ::: "memory");
        } else tok = gen + 1u;
    }
    __syncthreads();
    return tok;
}
__device__ __forceinline__ void xcd_barrier_finish(const XcdBarrier& b, unsigned tok) {
    if (threadIdx.x == 0) {
        if (tok) { XB_SPIN(xb_ld(&b.bar[XB_XGEN(b.x)]) == tok - 1u, b.bar); }
        __builtin_amdgcn_fence(__ATOMIC_ACQUIRE, "agent");
        asm volatile("s_waitcnt vmcnt(0)" ::: "memory");
    }
    __syncthreads();
}
using pg8::Unit; using pg8::HALF; using pg8::BM; using pg8::cvt_pk_bf16;

struct EpiRowScaleBf16 {
    bf16_t* O; int ldc; const float* rs;
    __device__ __forceinline__ void pre(float (&p)[24], const Unit& u, int wr, int wc, int fr, int fq) const {
#pragma unroll
        for (int ai = 0; ai < 2; ++ai)
#pragma unroll
            for (int m = 0; m < 4; ++m) p[ai * 4 + m] = rs[u.pm * BM + wr * 64 + fr + ai * HALF + m * 16]; }
    __device__ __forceinline__ void operator()(const f32x4 (&acc)[2][2][4][2], const Unit& u, int wr, int wc, int fr, int fq, const float (&p)[24]) const {
        const int row0 = u.pm * BM + wr * 64 + fr, col0 = u.pn * BM + wc * 32 + 8 * fq;
#pragma unroll
        for (int ai = 0; ai < 2; ++ai)
#pragma unroll
            for (int m = 0; m < 4; ++m) { const int row = row0 + ai * HALF + m * 16; const float s = p[ai * 4 + m]; bf16_t* rowp = O + (size_t)row * ldc + col0;
#pragma unroll
                for (int bj = 0; bj < 2; ++bj) { const f32x4 v0 = acc[ai][bj][m][0] * s, v1 = acc[ai][bj][m][1] * s;
                    u32x4 w; w.x = cvt_pk_bf16(v0[0], v0[1]); w.y = cvt_pk_bf16(v0[2], v0[3]); w.z = cvt_pk_bf16(v1[0], v1[1]); w.w = cvt_pk_bf16(v1[2], v1[3]);
                    *(u32x4*)(rowp + bj * HALF) = w; } }
    }
};

struct EpiResidual {
    bf16_t* X1; unsigned char* X1B;
    __device__ __forceinline__ void pre(float (&)[24], const Unit&, int, int, int, int) const {}
    __device__ __forceinline__ void operator()(const f32x4 (&acc)[2][2][4][2], const Unit& u, int wr, int wc, int fr, int fq, const float (&)[24]) const {
        const int row0 = u.pm * BM + wr * 64 + fr, col0 = u.pn * BM + wc * 32 + 8 * fq;
        constexpr int RD = 8;
        u32x4 xq[16];
#define ER_OFF(g) ((size_t)(row0 + ((g) >> 3) * HALF + (((g) >> 1) & 3) * 16) * DM + col0 + ((g) & 1) * HALF)
#pragma unroll
        for (int g = 0; g < RD; ++g) xq[g] = *(const u32x4*)(X1 + ER_OFF(g));
#pragma unroll
        for (int g = 0; g < 16; ++g) {
            if (g + RD < 16) xq[g + RD] = *(const u32x4*)(X1 + ER_OFF(g + RD));
            const int ai = g >> 3, m = (g >> 1) & 3, bj = g & 1; const size_t ro = ER_OFF(g);
            const f32x4 x0 = {bflo(xq[g].x), bfhi(xq[g].x), bflo(xq[g].y), bfhi(xq[g].y)}, x1 = {bflo(xq[g].z), bfhi(xq[g].z), bflo(xq[g].w), bfhi(xq[g].w)};
            const f32x4 v0 = acc[ai][bj][m][0] + x0, v1 = acc[ai][bj][m][1] + x1;
            { u32x4 wx; wx.x = pk2(v0[0], v0[1]); wx.y = pk2(v0[2], v0[3]); wx.z = pk2(v1[0], v1[1]); wx.w = pk2(v1[2], v1[3]); *(u32x4*)(X1 + ro) = wx; }
            if (MOE_ESZ == 2) { u32x4 w; w.x = cvt_pk_bf16(v0[0], v0[1]); w.y = cvt_pk_bf16(v0[2], v0[3]); w.z = cvt_pk_bf16(v1[0], v1[1]); w.w = cvt_pk_bf16(v1[2], v1[3]);
                *(u32x4*)(X1B + ro * 2) = w; }
            else { u32x2 w; w.x = pk4_fp8(v0[0], v0[1], v0[2], v0[3]); w.y = pk4_fp8(v1[0], v1[1], v1[2], v1[3]); *(u32x2*)(X1B + ro) = w; }
        }
#undef ER_OFF
    }
};

struct EpiSwiglu {
    const LAS int* meta; const LAS int* rows; const float* rs2; const float* bgu; unsigned char* H;
    __device__ __forceinline__ void pre(float (&p)[24], const Unit& u, int wr, int wc, int fr, int fq) const {
#pragma unroll
        for (int ai = 0; ai < 2; ++ai)
#pragma unroll
            for (int m = 0; m < 4; ++m) { const int aid = rows[u.ti * 256 + ai * HALF + wr * 64 + m * 16 + fr]; p[ai * 4 + m] = rs2[aid < 0 ? 0 : (aid >> 2)]; }
        const int e = __builtin_amdgcn_readfirstlane(meta[u.ti * 4 + 1]), pnl = __builtin_amdgcn_readfirstlane(meta[u.ti * 4 + 2]);
        const float* bp = bgu + (size_t)e * 2048 + 2 * (pnl * 128 + wc * 32 + 8 * fq);
#pragma unroll
        for (int q = 0; q < 4; ++q) { const f32x4 t = *(const f32x4*)(bp + 4 * q); p[8 + 4 * q] = t[0]; p[9 + 4 * q] = t[1]; p[10 + 4 * q] = t[2]; p[11 + 4 * q] = t[3]; } }
    __device__ __forceinline__ void operator()(const f32x4 (&acc)[2][2][4][2], const Unit& u, int wr, int wc, int fr, int fq, const float (&p)[24]) const {
        const int e = __builtin_amdgcn_readfirstlane(meta[u.ti * 4 + 1]), pnl = __builtin_amdgcn_readfirstlane(meta[u.ti * 4 + 2]);
        const int j0 = pnl * 128 + wc * 32 + 8 * fq;
        const float* bp = bgu + (size_t)e * 2048 + 2 * j0;
        float bg[8], bu[8];
#pragma unroll
        for (int q = 0; q < 4; ++q) { bg[2 * q] = p[8 + 4 * q]; bu[2 * q] = p[9 + 4 * q]; bg[2 * q + 1] = p[10 + 4 * q]; bu[2 * q + 1] = p[11 + 4 * q]; }
#pragma unroll
        for (int ai = 0; ai < 2; ++ai)
#pragma unroll
            for (int m = 0; m < 4; ++m) { const int r = ai * HALF + wr * 64 + m * 16 + fr; const int aid = rows[u.ti * 256 + r];
                const float s = p[ai * 4 + m]; unsigned char* rowp = H + ((size_t)(aid < 0 ? DUMMY_ROW : aid) * DM + j0) * MOE_ESZ;
                float o[8];
#pragma unroll
                for (int n = 0; n < 2; ++n)
#pragma unroll
                    for (int q = 0; q < 4; ++q) { float g = acc[ai][0][m][n][q] * s + bg[4 * n + q], up = acc[ai][1][m][n][q] * s + bu[4 * n + q];
                        g = fminf(g, 7.0f); up = fminf(fmaxf(up, -7.0f), 7.0f);
                        const float glu = g * __builtin_amdgcn_rcpf(1.0f + __expf(-1.702f * g));
                        o[4 * n + q] = (up + 1.0f) * glu; }
                if (MOE_ESZ == 2) { u32x4 w; w.x = cvt_pk_bf16(o[0], o[1]); w.y = cvt_pk_bf16(o[2], o[3]); w.z = cvt_pk_bf16(o[4], o[5]); w.w = cvt_pk_bf16(o[6], o[7]); *(u32x4*)rowp = w; }
                else { u32x2 w; w.x = pk4_fp8(o[0], o[1], o[2], o[3]); w.y = pk4_fp8(o[4], o[5], o[6], o[7]); *(u32x2*)rowp = w; } }
    }
};

struct EpiDown {
    const LAS int* meta; const LAS int* rows; const float* topw; const float* bdn; unsigned char* Y;
    __device__ __forceinline__ void pre(float (&p)[24], const Unit& u, int wr, int wc, int fr, int fq) const {
#pragma unroll
        for (int ai = 0; ai < 2; ++ai)
#pragma unroll
            for (int m = 0; m < 4; ++m) { const int aid = rows[u.ti * 256 + ai * HALF + wr * 64 + m * 16 + fr]; p[ai * 4 + m] = topw[aid < 0 ? 0 : aid]; }
        const int e = __builtin_amdgcn_readfirstlane(meta[u.ti * 4 + 1]), pnl = __builtin_amdgcn_readfirstlane(meta[u.ti * 4 + 2]);
        const int col0 = pnl * BM + wc * 32 + 8 * fq;
#pragma unroll
        for (int bj = 0; bj < 2; ++bj)
#pragma unroll
            for (int n = 0; n < 2; ++n) { const f32x4 t = *(const f32x4*)(bdn + (size_t)e * DM + col0 + bj * HALF + 4 * n); p[8 + (bj * 2 + n) * 4] = t[0]; p[9 + (bj * 2 + n) * 4] = t[1]; p[10 + (bj * 2 + n) * 4] = t[2]; p[11 + (bj * 2 + n) * 4] = t[3]; } }
    __device__ __forceinline__ void operator()(const f32x4 (&acc)[2][2][4][2], const Unit& u, int wr, int wc, int fr, int fq, const float (&p)[24]) const {
        const int e = __builtin_amdgcn_readfirstlane(meta[u.ti * 4 + 1]), pnl = __builtin_amdgcn_readfirstlane(meta[u.ti * 4 + 2]);
        const int col0 = pnl * BM + wc * 32 + 8 * fq;
        f32x4 bv[2][2];
#pragma unroll
        for (int bj = 0; bj < 2; ++bj)
#pragma unroll
            for (int n = 0; n < 2; ++n) bv[bj][n] = (f32x4){p[8 + (bj * 2 + n) * 4], p[9 + (bj * 2 + n) * 4], p[10 + (bj * 2 + n) * 4], p[11 + (bj * 2 + n) * 4]};
#pragma unroll
        for (int ai = 0; ai < 2; ++ai)
#pragma unroll
            for (int m = 0; m < 4; ++m) { const int r = ai * HALF + wr * 64 + m * 16 + fr; const int aid = rows[u.ti * 256 + r];
                const float s = p[ai * 4 + m] * YE_SCALE; unsigned char* rowp = Y + ((size_t)(aid < 0 ? DUMMY_ROW : aid) * DM + col0) * YE_ESZ;
#pragma unroll
                for (int bj = 0; bj < 2; ++bj) { const f32x4 v0 = (acc[ai][bj][m][0] + bv[bj][0]) * s, v1 = (acc[ai][bj][m][1] + bv[bj][1]) * s;
                    if (YE_ESZ == 2) { u32x4 w; w.x = cvt_pk_bf16(v0[0], v0[1]); w.y = cvt_pk_bf16(v0[2], v0[3]); w.z = cvt_pk_bf16(v1[0], v1[1]); w.w = cvt_pk_bf16(v1[2], v1[3]);
                        *(u32x4*)(rowp + bj * HALF * 2) = w; }
                    else { u32x2 w; w.x = pk4_fp8(v0[0], v0[1], v0[2], v0[3]); w.y = pk4_fp8(v1[0], v1[1], v1[2], v1[3]); *(u32x2*)(rowp + bj * HALF) = w; } } }
    }
};

struct Frame {
    LAS unsigned char* lds; int tid, lane, wave, G, bid;
    const float* const* in; float* out; unsigned char* ws;
    __device__ __forceinline__ unsigned* ctl() const { return (unsigned*)(ws + WS_CTL); }
};

__device__ __forceinline__ void p0_rows(const Frame& F) {
    const float* x = F.in[I_X]; bf16_t* XB = (bf16_t*)(F.ws + WS_XB); float* RS1 = (float*)(F.ws + WS_RS1); float* XP = (float*)(F.ws + WS_XPART);
    LAS float* red = (LAS float*)F.lds;
    for (int g = F.bid; g < NTOK / 64; g += F.G) {
        float xs[16];
#pragma unroll
        for (int i = 0; i < 16; ++i) xs[i] = 0.f;
#pragma unroll 4
        for (int i = 0; i < 8; ++i) { const int row = g * 64 + F.wave * 8 + i; const float* xr = x + (size_t)row * DM;
            f32x4 v[4]; float ss = 0.f;
#pragma unroll
            for (int j = 0; j < 4; ++j) { v[j] = *(const f32x4*)(xr + 256 * j + 4 * F.lane); ss += v[j][0] * v[j][0] + v[j][1] * v[j][1] + v[j][2] * v[j][2] + v[j][3] * v[j][3]; }
            ss = wave_sum(ss); const float rs = rsqrtf(ss * (1.0f / DM) + 1e-5f);
            if (F.lane == 0) RS1[row] = rs;
#pragma unroll
            for (int j = 0; j < 4; ++j) { u32x2 w; w.x = pk2(v[j][0], v[j][1]); w.y = pk2(v[j][2], v[j][3]); *(u32x2*)(XB + (size_t)row * DM + 256 * j + 4 * F.lane) = w;
#pragma unroll
                for (int e = 0; e < 4; ++e) xs[4 * j + e] += rs * v[j][e]; } }
#pragma unroll
        for (int j = 0; j < 4; ++j)
#pragma unroll
            for (int e = 0; e < 4; ++e) red[F.wave * 1024 + 256 * j + 4 * F.lane + e] = xs[4 * j + e];
        __syncthreads();
        for (int c = F.tid; c < 1024; c += NTHREADS) { float s = 0.f;
#pragma unroll
            for (int w = 0; w < 8; ++w) s += red[w * 1024 + c];
            XP[(size_t)g * 1024 + c] = s; }
        __syncthreads();
    }
    const float* mem = F.in[I_MEM]; bf16_t* MB = (bf16_t*)(F.ws + WS_MEMB); float* RSM = (float*)(F.ws + WS_RS1 + 65536);
    for (int row = F.bid * 8 + F.wave; row < NB * NMEM; row += F.G * 8) { const float* xr = mem + (size_t)row * DM;
        f32x4 v[4]; float ss = 0.f;
#pragma unroll
        for (int j = 0; j < 4; ++j) { v[j] = *(const f32x4*)(xr + 256 * j + 4 * F.lane); ss += v[j][0] * v[j][0] + v[j][1] * v[j][1] + v[j][2] * v[j][2] + v[j][3] * v[j][3]; }
        ss = wave_sum(ss); if (F.lane == 0) RSM[row] = rsqrtf(ss * (1.0f / DM) + 1e-5f);
#pragma unroll
        for (int j = 0; j < 4; ++j) { u32x2 w; w.x = pk2(v[j][0], v[j][1]); w.y = pk2(v[j][2], v[j][3]); *(u32x2*)(MB + (size_t)row * DM + 256 * j + 4 * F.lane) = w; }
    }
}

struct TJob { const float* src; bf16_t* dst; const float* gk; int K, N, ntk, ntn, perm; size_t es_src, es_dst; int qs = 0; };
__device__ __forceinline__ int tjob_destrow(const TJob& J, int n) { if (!J.perm) return n; const int j = n >> 1, up = n & 1; return (j >> 7) * 256 + up * 128 + (j & 127); }
__device__ __forceinline__ void tjob_load(const TJob& J, int t, int tid, f32x4 (&v)[4], f32x4& g) {
    const int per = J.ntk * J.ntn, e = t / per, tile = t % per;
    const int tk = tile % J.ntk, tn = tile / J.ntk; const int r = tid >> 5, c4 = (tid & 31) * 4;
    const float* src = J.src + (size_t)e * J.es_src;
#pragma unroll
    for (int p = 0; p < 4; ++p) { const int k = tk * 64 + p * 16 + r; v[p] = *(const f32x4*)(src + (size_t)k * J.N + tn * 128 + c4); g[p] = J.gk ? J.gk[k] : 1.0f; }
}
__device__ __forceinline__ void tjob_store(const TJob& J, int t, int tid, const f32x4 (&v)[4], const f32x4& gs, LAS float* T  ) {
    const int per = J.ntk * J.ntn, e = t / per, tile = t % per;
    const int tk = tile % J.ntk, tn = tile / J.ntk; const int r = tid >> 5, c = tid & 31, rot = c >> 3;
    const float cs = (J.qs && (tn < 3 || tn >= 20)) ? 0.125f * 1.4426950408889634f : 1.0f;
#pragma unroll
    for (int p = 0; p < 4; ++p) { const float g = gs[p] * cs;
#pragma unroll
        for (int q = 0; q < 4; ++q) { const int ee = (q + rot) & 3;
            const float x = ee == 0 ? v[p][0] : ee == 1 ? v[p][1] : ee == 2 ? v[p][2] : v[p][3];
            T[(4 * c + ee) * 65 + p * 16 + r] = x * g; } }
    __syncthreads();
    const int n = tid >> 2, ks = (tid & 3) * 8;
    float f[16];
#pragma unroll
    for (int i = 0; i < 8; ++i) { f[i] = T[n * 65 + ks + i]; f[8 + i] = T[n * 65 + 32 + ks + i]; }
    u32x4 w0, w1; w0.x = pk2(f[0], f[1]); w0.y = pk2(f[2], f[3]); w0.z = pk2(f[4], f[5]); w0.w = pk2(f[6], f[7]); w1.x = pk2(f[8], f[9]); w1.y = pk2(f[10], f[11]); w1.z = pk2(f[12], f[13]); w1.w = pk2(f[14], f[15]);
    bf16_t* d = J.dst + (size_t)e * J.es_dst + (size_t)tjob_destrow(J, tn * 128 + n) * J.K + tk * 64 + ks;
    *(u32x4*)d = w0; *(u32x4*)(d + 32) = w1;
    __syncthreads();
}
__device__ __forceinline__ void run_tjob(const Frame& F, const TJob& J, int nexp, int voff = 0) {
    const int total = J.ntk * J.ntn * nexp, G = F.G;
    LAS float* T = (LAS float*)F.lds;
    f32x4 va[4], vb[4], vc[4], ga, gb, gc;
    const int t0 = (F.bid + G - voff) % G;
    if (t0 < total) tjob_load(J, t0, F.tid, va, ga);
    if (t0 + G < total) tjob_load(J, t0 + G, F.tid, vb, gb);
    if (t0 + 2 * G < total) tjob_load(J, t0 + 2 * G, F.tid, vc, gc);
    for (int t = t0; t < total; t += 3 * G) {
        tjob_store(J, t, F.tid, va, ga, T); if (t + 3 * G < total) tjob_load(J, t + 3 * G, F.tid, va, ga);
        if (t + G < total) { tjob_store(J, t + G, F.tid, vb, gb, T); if (t + 4 * G < total) tjob_load(J, t + 4 * G, F.tid, vb, gb); }
        if (t + 2 * G < total) { tjob_store(J, t + 2 * G, F.tid, vc, gc, T); if (t + 5 * G < total) tjob_load(J, t + 5 * G, F.tid, vc, gc); }
    }
}

__device__ __forceinline__ void p0_prologue(const Frame& F) {
    if (F.bid == 0 && F.tid < 64) F.ctl()[F.tid] = 0u;
    p0_rows(F);
    const float* const* in = F.in;
    { TJob J{in[I_WIN], (bf16_t*)(F.ws + WS_WIN), in[I_GMIX], 1024, INC, 16, INC / 128, 0, 0, 0, 1}; run_tjob(F, J, 1); }
    { TJob J{in[I_WOUT], (bf16_t*)(F.ws + WS_WOUT), nullptr, 1024, 1024, 16, 8, 0, 0, 0}; run_tjob(F, J, 1, 96); }
    { TJob J{in[I_WMKV], (bf16_t*)(F.ws + WS_WMKV), in[I_GMEM], 1024, 512, 16, 4, 0, 0, 0}; run_tjob(F, J, 1, 224); }
    { TJob J{in[I_WUP], (bf16_t*)(F.ws + WS_LORA), nullptr, 64, 384, 1, 3, 0, 0, 0}; run_tjob(F, J, 1, 32); }
    { TJob J{in[I_AUP], (bf16_t*)(F.ws + WS_LORA) + 384 * 64, nullptr, 64, 384, 1, 3, 0, 0, 0}; run_tjob(F, J, 1, 35); }
    { TJob J{in[I_GUP], (bf16_t*)(F.ws + WS_LORA) + 2 * 384 * 64, nullptr, 128, 384, 2, 3, 0, 0, 0}; run_tjob(F, J, 1, 38); }
}
constexpr int MOE_T1 = 16 * 16 * NEXP, MOE_T2 = 16 * 8 * NEXP, MOE_TT = MOE_T1 + MOE_T2;
struct MoeTile { const float* src; unsigned char* dst; int N, gate, tk, tn; };
__device__ __forceinline__ MoeTile moe_tile(const float* wgu, const float* wdn, unsigned char* dgu, unsigned char* ddn, int t) {
    const bool first = t < MOE_T1; const int tt = first ? t : t - MOE_T1; const int per = first ? 256 : 128, e = first ? (tt >> 8) : (tt >> 7), tile = tt & (per - 1);
    MoeTile m; m.N = first ? 2048 : 1024; m.gate = first ? 1 : 0; m.tk = tile & 15; m.tn = tile >> 4;
    m.src = first ? wgu + (size_t)e * 1024 * 2048 : wdn + (size_t)e * 1024 * 1024; m.dst = first ? dgu + (size_t)e * 2048 * 1024 * MOE_ESZ : ddn + (size_t)e * 1024 * 1024 * MOE_ESZ; return m;
}
__device__ __forceinline__ void moe_tile_load(const MoeTile& m, int tid, f32x4 (&v)[4]) {
    const int r = tid >> 5, c4 = (tid & 31) * 4;
#pragma unroll
    for (int p = 0; p < 4; ++p) v[p] = __builtin_nontemporal_load((const f32x4*)(m.src + (size_t)(m.tk * 64 + (MOE_ESZ == 1 ? 4 * r + p : p * 16 + r)) * m.N + m.tn * 128 + c4));
}
__device__ __forceinline__ void moe_tile_store(const MoeTile& m, int tid, const f32x4 (&v)[4], LAS float* T, const LAS float* GT) {
    const int r = tid >> 5, c = tid & 31, rot = c >> 3;
    const int n = tid >> 2;
    const int nn = m.tn * 128 + n, j = nn >> 1; const int drow = m.gate ? ((j >> 7) * 256 + (nn & 1) * 128 + (j & 127)) : nn;
    if (MOE_ESZ == 1) {
        LAS unsigned* T2 = (LAS unsigned*)T;
        float g[4];
#pragma unroll
        for (int p = 0; p < 4; ++p) g[p] = (m.gate ? GT[m.tk * 64 + 4 * r + p] : 1.0f) * (float)(1 << pg8::W8_SHIFT);
#pragma unroll
        for (int q = 0; q < 4; ++q) { const int ee = (q + rot) & 3;
            const float x0 = ee == 0 ? v[0][0] : ee == 1 ? v[0][1] : ee == 2 ? v[0][2] : v[0][3], x1 = ee == 0 ? v[1][0] : ee == 1 ? v[1][1] : ee == 2 ? v[1][2] : v[1][3];
            const float x2 = ee == 0 ? v[2][0] : ee == 1 ? v[2][1] : ee == 2 ? v[2][2] : v[2][3], x3 = ee == 0 ? v[3][0] : ee == 1 ? v[3][1] : ee == 2 ? v[3][2] : v[3][3];
            T2[(4 * c + ee) * 17 + r] = pk4_fp8(x0 * g[0], x1 * g[1], x2 * g[2], x3 * g[3]); }
        __syncthreads();
        const int qd = (tid & 3) * 4;
        u32x4 w; w.x = T2[n * 17 + qd]; w.y = T2[n * 17 + qd + 1]; w.z = T2[n * 17 + qd + 2]; w.w = T2[n * 17 + qd + 3];
        __builtin_nontemporal_store(w, (u32x4*)(m.dst + (size_t)drow * 1024 + m.tk * 64 + 4 * qd));
        __syncthreads();
    } else {
#pragma unroll
        for (int p = 0; p < 4; ++p) { const float gk = GT[m.tk * 64 + p * 16 + r]; const float g = m.gate ? gk : 1.0f;
#pragma unroll
            for (int q = 0; q < 4; ++q) { const int ee = (q + rot) & 3;
                const float x = ee == 0 ? v[p][0] : ee == 1 ? v[p][1] : ee == 2 ? v[p][2] : v[p][3];
                T[(4 * c + ee) * 65 + p * 16 + r] = x * g; } }
        __syncthreads();
        const int ks = (tid & 3) * 16;
        float f[16];
#pragma unroll
        for (int i = 0; i < 16; ++i) f[i] = T[n * 65 + ks + i];
        unsigned char* d = m.dst + ((size_t)drow * 1024 + m.tk * 64 + ks) * 2;
        u32x4 w0, w1; w0.x = pk2(f[0], f[1]); w0.y = pk2(f[2], f[3]); w0.z = pk2(f[4], f[5]); w0.w = pk2(f[6], f[7]); w1.x = pk2(f[8], f[9]); w1.y = pk2(f[10], f[11]); w1.z = pk2(f[12], f[13]); w1.w = pk2(f[14], f[15]);
        *(u32x4*)d = w0; *(u32x4*)(d + 16) = w1;
        __syncthreads();
    }
}
struct TileSeq { int a0, sa, n1, b0, sb, n;
    __device__ __forceinline__ int at(int i) const { return i < n1 ? a0 + i * sa : b0 + (i - n1) * sb; } };
__device__ __forceinline__ void moe_convert_seq(const Frame& F, const TileSeq& q, bool need_gt = true) {
    const float* wgu = F.in[I_WGU]; const float* wdn = F.in[I_WDN]; unsigned char* dgu = F.ws + WS_WGU; unsigned char* ddn = F.ws + WS_WDN;
    LAS float* T = (LAS float*)F.lds; LAS float* GT = T + 128 * 65;
    __syncthreads();
    if (need_gt) { for (int i = F.tid; i < 1024; i += NTHREADS) GT[i] = F.in[I_GFFN][i];
        __syncthreads(); }
    const int n = q.n;
    f32x4 va[4], vb4[4], vc[4];
    MoeTile mA = moe_tile(wgu, wdn, dgu, ddn, q.at(0 < n ? 0 : 0)), mB = moe_tile(wgu, wdn, dgu, ddn, q.at(1 < n ? 1 : 0)), mC = moe_tile(wgu, wdn, dgu, ddn, q.at(2 < n ? 2 : 0));
    if (n == 0) return;
    moe_tile_load(mA, F.tid, va); moe_tile_load(mB, F.tid, vb4); moe_tile_load(mC, F.tid, vc);
    int i = 0;
    for (; i + 5 < n; i += 3) {
        moe_tile_store(mA, F.tid, va, T, GT); mA = moe_tile(wgu, wdn, dgu, ddn, q.at(i + 3)); moe_tile_load(mA, F.tid, va);
        moe_tile_store(mB, F.tid, vb4, T, GT); mB = moe_tile(wgu, wdn, dgu, ddn, q.at(i + 4)); moe_tile_load(mB, F.tid, vb4);
        moe_tile_store(mC, F.tid, vc, T, GT); mC = moe_tile(wgu, wdn, dgu, ddn, q.at(i + 5)); moe_tile_load(mC, F.tid, vc);
    }
    for (; i < n; i += 3) {
        moe_tile_store(mA, F.tid, va, T, GT); if (i + 3 < n) { mA = moe_tile(wgu, wdn, dgu, ddn, q.at(i + 3)); moe_tile_load(mA, F.tid, va); }
        if (i + 1 < n) { moe_tile_store(mB, F.tid, vb4, T, GT); if (i + 4 < n) { mB = moe_tile(wgu, wdn, dgu, ddn, q.at(i + 4)); moe_tile_load(mB, F.tid, vb4); } }
        if (i + 2 < n) { moe_tile_store(mC, F.tid, vc, T, GT); if (i + 5 < n) { mC = moe_tile(wgu, wdn, dgu, ddn, q.at(i + 5)); moe_tile_load(mC, F.tid, vc); } }
    }
}
__device__ __forceinline__ void moe_weight_conversion(const Frame& F, int vb, int NC, int X, int END) {
    TileSeq q; q.a0 = vb; q.sa = NC; q.n1 = (vb >= 0 && vb < X) ? (X - vb + NC - 1) / NC : 0; q.b0 = X + F.bid; q.sb = F.G; q.n = q.n1 + ((X + F.bid < END) ? (END - X - F.bid + F.G - 1) / F.G : 0);
    moe_convert_seq(F, q);
}
__device__ __forceinline__ void moe_convert_run(const Frame& F, int lo, int cnt, bool need_gt) { TileSeq q; q.a0 = lo; q.sa = 1; q.n1 = cnt; q.b0 = 0; q.sb = 0; q.n = cnt; moe_convert_seq(F, q, need_gt); }

#if defined(TIMING_SCAFFOLD)
__device__ __forceinline__ void exp_stream_read(const Frame& F, int mode) {
    const float* src = F.in[I_WGU]; const size_t n4 = (size_t)NEXP * 1024 * 2048 / 4;
    f32x4 acc = {0.f, 0.f, 0.f, 0.f};
    if (mode == 1) {
        for (size_t i = (size_t)F.bid * NTHREADS + F.tid; i < n4; i += (size_t)F.G * NTHREADS * 8) {
#pragma unroll
            for (int u = 0; u < 8; ++u) { const size_t j = i + (size_t)u * F.G * NTHREADS; if (j < n4) acc += *(const f32x4*)(src + 4 * j); } }
    } else {
        const int r = F.tid >> 5, c4 = (F.tid & 31) * 4;
        for (int t = F.bid; t < MOE_T1; t += F.G) { const int e = t / 256, tile = t % 256, tk = tile % 16, tn = tile / 16;
            const float* s = src + (size_t)e * 1024 * 2048;
#pragma unroll
            for (int p = 0; p < 4; ++p) acc += *(const f32x4*)(s + (size_t)(tk * 64 + p * 16 + r) * 2048 + tn * 128 + c4); }
    }
    if (acc[0] + acc[1] + acc[2] + acc[3] == 1.2345e33f) F.out[0] = 0.f;
}
#endif

__device__ __forceinline__ void kmean_task(const Frame& F) {
    const float* XP = (const float*)(F.ws + WS_XPART); const bf16_t* W = (const bf16_t*)(F.ws + WS_WIN) + (size_t)C_K * DM; float* KM = (float*)(F.ws + WS_KM);
    for (int o = (F.bid * 8 + F.wave) * 12; o < 64 * 384; o += F.G * 8 * 12) {
        const int n = o / 384;
        float xb[16];
#pragma unroll
        for (int i = 0; i < 16; ++i) xb[i] = 0.f;
#pragma unroll
        for (int q = 0; q < 4; ++q)
#pragma unroll
            for (int j = 0; j < 4; ++j) { const f32x4 t = *(const f32x4*)(XP + (size_t)(4 * n + q) * 1024 + 16 * F.lane + 4 * j); xb[4 * j] += t[0]; xb[4 * j + 1] += t[1]; xb[4 * j + 2] += t[2]; xb[4 * j + 3] += t[3]; }
        u32x4 w0s[12], w1s[12];
#pragma unroll
        for (int i = 0; i < 12; ++i) { const int c = (o + i) % 384; w0s[i] = *(const u32x4*)(W + (size_t)c * DM + 16 * F.lane); w1s[i] = *(const u32x4*)(W + (size_t)c * DM + 16 * F.lane + 8); }
#pragma unroll
        for (int i = 0; i < 12; ++i) { const u32x4 w0 = w0s[i], w1 = w1s[i];
            float s = xb[0] * bflo(w0.x) + xb[1] * bfhi(w0.x) + xb[2] * bflo(w0.y) + xb[3] * bfhi(w0.y) + xb[4] * bflo(w0.z) + xb[5] * bfhi(w0.z) + xb[6] * bflo(w0.w) + xb[7] * bfhi(w0.w)
                    + xb[8] * bflo(w1.x) + xb[9] * bfhi(w1.x) + xb[10] * bflo(w1.y) + xb[11] * bfhi(w1.y) + xb[12] * bflo(w1.z) + xb[13] * bfhi(w1.z) + xb[14] * bflo(w1.w) + xb[15] * bfhi(w1.w);
            s = wave_sum(s); if (F.lane == 0) KM[o + i] = s * (1.0f / 256.0f); }
    }
}

__device__ __forceinline__ void router_stage_w(const Frame& F) {
    const float* wr = F.in[I_WR]; const float* gf = F.in[I_GFFN];
    LAS float* W = (LAS float*)F.lds;
#pragma unroll
    for (int it_ = 0; it_ < 16; ++it_) { const int i = F.tid + it_ * NTHREADS; const int k = i >> 3, e0 = (i & 7) * 4; f32x4 t = *(const f32x4*)(wr + 4 * i); t = t * gf[k];
        const int rho = (k & ~15) | ((k & 3) << 2) | ((k >> 2) & 3);
#pragma unroll
        for (int q = 0; q < 4; ++q) { const int e = e0 + q; W[rho * 32 + ((e & 15) << 1) + (e >> 4)] = t[q]; } }
}
__device__ __forceinline__ void router_phase(const Frame& F, bool dry = false, bool stage_w = true) {
    const bf16_t* X1 = (const bf16_t*)(F.ws + WS_XB); const float* wr = F.in[I_WR]; const float* gf = F.in[I_GFFN]; const float* br = F.in[I_BR];
    float* RS2 = (float*)(F.ws + WS_RS1 + 131072); float* TOPW = (float*)(F.ws + WS_TOPW); int* LIST = (int*)(F.ws + WS_LIST); unsigned* CNT = F.ctl();
    LAS float* W = (LAS float*)F.lds;
    LAS int* lcnt = (LAS int*)(F.lds + XTRA_OFF); LAS int* lbase = lcnt + 32; LAS int* lexp = lcnt + 64; LAS int* lrank = lcnt + 64 + 256;
    LAS float* LG = (LAS float*)(lcnt + 64 + 512); LAS float* SS = LG + 2 * 64 * 33;
    if (stage_w) router_stage_w(F);
    for (int g = F.bid; g < NTOK / 64; g += F.G) {
        if (F.tid < 32) lcnt[F.tid] = 0;
        __syncthreads();
        {
            const int i = F.lane & 15, kq = F.lane >> 4, tg = F.wave & 3, kh = F.wave >> 2; const bf16_t* xr = X1 + (size_t)(g * 64 + 16 * tg + i) * DM + 512 * kh + 4 * kq;
            f32x4 a0 = {0.f, 0.f, 0.f, 0.f}, a1 = {0.f, 0.f, 0.f, 0.f}; float ss = 0.f;
#pragma unroll 16
            for (int q = 0; q < 32; ++q) { const u32x2 xw = *(const u32x2*)(xr + 16 * q); const f32x4 xv = {bflo(xw.x), bfhi(xw.x), bflo(xw.y), bfhi(xw.y)}; ss += xv[0] * xv[0] + xv[1] * xv[1] + xv[2] * xv[2] + xv[3] * xv[3];
#pragma unroll
                for (int j = 0; j < 4; ++j) { const f32x2 b = *(const LAS f32x2*)(W + (512 * kh + 16 * q + 4 * j + kq) * 32 + 2 * i);
                    a0 = __builtin_amdgcn_mfma_f32_16x16x4f32(xv[j], b[0], a0, 0, 0, 0); a1 = __builtin_amdgcn_mfma_f32_16x16x4f32(xv[j], b[1], a1, 0, 0, 0); } }
            ss += __shfl_xor(ss, 16); ss += __shfl_xor(ss, 32);
            if (F.lane < 16) SS[kh * 64 + 16 * tg + i] = ss;
#pragma unroll
            for (int r = 0; r < 4; ++r) { LG[(kh * 64 + 16 * tg + 4 * kq + r) * 33 + i] = a0[r]; LG[(kh * 64 + 16 * tg + 4 * kq + r) * 33 + 16 + i] = a1[r]; }
        }
        __syncthreads();
        if (F.wave == 0) {
            const int tl = F.lane; const float rs = rsqrtf((SS[tl] + SS[64 + tl]) * (1.0f / DM) + 1e-5f);
            float lg[32];
#pragma unroll
            for (int q = 0; q < 32; ++q) lg[q] = (LG[tl * 33 + q] + LG[(64 + tl) * 33 + q]) * rs + br[q];
            float tv[4]; int te[4];
#pragma unroll
            for (int r = 0; r < 4; ++r) { float bv = -INFINITY; int bi = 0;
#pragma unroll
                for (int q = 0; q < 32; ++q) { const bool tk = lg[q] > bv; bv = tk ? lg[q] : bv; bi = tk ? q : bi; }
                tv[r] = bv; te[r] = bi;
#pragma unroll
                for (int q = 0; q < 32; ++q) lg[q] = (q == bi) ? -INFINITY : lg[q]; }
            const float e1 = __expf(tv[1] - tv[0]), e2 = __expf(tv[2] - tv[0]), e3 = __expf(tv[3] - tv[0]); const float inv = 1.0f / (1.0f + e1 + e2 + e3);
            *(f32x4*)(TOPW + (size_t)(g * 64 + tl) * 4) = (f32x4){inv, e1 * inv, e2 * inv, e3 * inv};
#pragma unroll
            for (int k = 0; k < 4; ++k) { lexp[tl * 4 + k] = te[k]; lrank[tl * 4 + k] = __hip_atomic_fetch_add(&lcnt[te[k]], 1, __ATOMIC_RELAXED, __HIP_MEMORY_SCOPE_WORKGROUP); }
            RS2[g * 64 + tl] = rs;
        }
        __syncthreads();
        if (F.tid < 32 && !dry) lbase[F.tid] = (int)atomicAdd(&CNT[F.tid], (unsigned)lcnt[F.tid]);
        __syncthreads();
        if (F.tid < 256 && !dry) { const int ek = lexp[F.tid]; LIST[(size_t)ek * NTOK + lbase[ek] + lrank[F.tid]] = g * 256 + F.tid; }
        __syncthreads();
    }
}

constexpr int MAXU_GU = 10, MAXU_DN = 6, UTAB_DN_OFF = 10752;
struct UTab { LAS int* meta; LAS int* rows; LAS int* pre; int nunits; };
template <int MAXU>
__device__ __forceinline__ UTab build_unit_table(const Frame& F, int nN, int lds_off) {
    UTab T; T.pre = (LAS int*)(F.lds + XTRA_OFF + lds_off); T.meta = T.pre + 80; T.rows = T.meta + MAXU * 4;
    const unsigned* CNT = F.ctl(); const int* LIST = (const int*)(F.ws + WS_LIST);
    LAS int* cnts = T.pre + 40;
    if (F.tid < NEXP) cnts[F.tid] = (int)CNT[F.tid];
    __syncthreads();
    if (F.tid == 0) { int s = 0; for (int e = 0; e < NEXP; ++e) { T.pre[e] = s; s += (cnts[e] + 255) >> 8; } T.pre[NEXP] = s; }
    __syncthreads();
    const int RT = T.pre[NEXP], U = RT * nN;
    int nu = 0;
    for (int i = 0; i < MAXU; ++i) { const int L = i * F.G + F.bid; if (L >= U) break;
        const int wgid = pg8::xcd_remap(L, U); const int rtg = wgid / nN, pn = wgid % nN;
        int e = 0; for (int q = 1; q < NEXP; ++q) if (T.pre[q] <= rtg) e = q;
        const int r = rtg - T.pre[e];
        if (F.tid == 0) { T.meta[i * 4] = e * nN + pn; T.meta[i * 4 + 1] = e; T.meta[i * 4 + 2] = pn; T.meta[i * 4 + 3] = r; }
        nu = i + 1; }
    __syncthreads();
    if (F.tid < 256) {
        int av[MAXU];
#pragma unroll
        for (int i = 0; i < MAXU; ++i) { av[i] = -1; if (i < nu) { const int e = T.meta[i * 4 + 1], r = T.meta[i * 4 + 3]; const int idx = r * 256 + F.tid; if (idx < cnts[e]) av[i] = LIST[(size_t)e * NTOK + idx]; } }
#pragma unroll
        for (int i = 0; i < MAXU; ++i) if (i < nu) T.rows[i * 256 + F.tid] = av[i];
    }
    __syncthreads();
    T.nunits = nu; return T;
}

__device__ __forceinline__ void final_phase(const Frame& F, bool dry = false) {
    const unsigned char* YE = F.ws + WS_YE; const float* gfin = F.in[I_GFIN]; float* out = F.out; const bf16_t* X1 = (const bf16_t*)(F.ws + WS_XB);
    f32x4 gv[4];
#pragma unroll
    for (int j = 0; j < 4; ++j) gv[j] = *(const f32x4*)(gfin + 256 * j + 4 * F.lane);
    static_assert(YE_ESZ == 1, "final_phase reads fp8 expert outputs");
    struct RowRegs { u32x2 x[4]; u32x4 y[4]; };
    const int first = F.bid * 8 + F.wave, stride = F.G * 8;
    const int nrows = first < NTOK ? (NTOK - first + stride - 1) / stride : 0, lastrow = first + (nrows - 1) * stride;
    auto ld = [&](int row, RowRegs& R) { row = row < lastrow ? row : lastrow;
#pragma unroll
        for (int j = 0; j < 4; ++j) R.x[j] = *(const u32x2*)(X1 + (size_t)row * DM + 256 * j + 4 * F.lane);
#pragma unroll
        for (int k = 0; k < 4; ++k)
#pragma unroll
            for (int j = 0; j < 4; ++j) R.y[k][j] = *(const unsigned*)(YE + (size_t)(row * 4 + k) * DM + 256 * j + 4 * F.lane); };
    auto proc = [&](int row, const RowRegs& R) { row = row < lastrow ? row : lastrow;
        float v[16];
#pragma unroll
        for (int j = 0; j < 4; ++j) { const u32x2 t = R.x[j]; v[4 * j] = bflo(t.x); v[4 * j + 1] = bfhi(t.x); v[4 * j + 2] = bflo(t.y); v[4 * j + 3] = bfhi(t.y); }
#pragma unroll
        for (int k = 0; k < 4; ++k)
#pragma unroll
            for (int j = 0; j < 4; ++j) { const unsigned d = R.y[k][j];
                const f32x2 lo = __builtin_amdgcn_cvt_pk_f32_fp8(d, false), hi = __builtin_amdgcn_cvt_pk_f32_fp8(d, true);
                v[4 * j] += lo[0] * (1.0f / YE_SCALE); v[4 * j + 1] += lo[1] * (1.0f / YE_SCALE); v[4 * j + 2] += hi[0] * (1.0f / YE_SCALE); v[4 * j + 3] += hi[1] * (1.0f / YE_SCALE); }
        float ss = 0.f;
#pragma unroll
        for (int i = 0; i < 16; ++i) ss += v[i] * v[i];
        ss = wave_sum(ss); const float rs = rsqrtf(ss * (1.0f / DM) + 1e-5f);
#pragma unroll
        for (int j = 0; j < 4; ++j) { f32x4 o; o[0] = v[4 * j] * rs * gv[j][0]; o[1] = v[4 * j + 1] * rs * gv[j][1]; o[2] = v[4 * j + 2] * rs * gv[j][2]; o[3] = v[4 * j + 3] * rs * gv[j][3];
            if (!dry) *(f32x4*)(out + (size_t)row * DM + 256 * j + 4 * F.lane) = o; else if (o[0] == 1.2345e30f) out[0] = 0.f; } };
    if (nrows == 0) return;
    RowRegs A, B;
    if (nrows == 8) {
        ld(first, A); ld(first + stride, B);
#pragma unroll
        for (int i = 0; i < 8; i += 2) { const int row = first + i * stride;
#define FP_PIN(R) asm volatile("" : "+v"(R.x[0]), "+v"(R.x[1]), "+v"(R.x[2]), "+v"(R.x[3]), "+v"(R.y[0]), "+v"(R.y[1]), "+v"(R.y[2]), "+v"(R.y[3]))
            FP_PIN(A); proc(row, A); if (i + 2 < 8) ld(row + 2 * stride, A); __builtin_amdgcn_sched_barrier(0);
            FP_PIN(B); proc(row + stride, B); if (i + 3 < 8) ld(row + 3 * stride, B); __builtin_amdgcn_sched_barrier(0); }
#undef FP_PIN
    } else {
#pragma unroll 1
        for (int i = 0; i < nrows; ++i) { ld(first + i * stride, A); proc(first + i * stride, A); }
    }
}
__device__ __forceinline__ int crow(int r, int hi) { return (r & 3) + 8 * (r >> 2) + 4 * hi; }
constexpr int AT_KB = 0, AT_VB = 4 * 9216, AT_LUT = 8 * 9216, AT_UNIT = AT_LUT + 6 * 2560, AT_KM = AT_UNIT + 64;
template <int B> struct ATIC { static constexpr int v = B; };
constexpr float LOG2E = 1.4426950408889634f;
constexpr float AT_THR = 8.0f;

__device__ __forceinline__ void half_swap(float v, float& lo, float& hi_) {
    const auto rr = __builtin_amdgcn_permlane32_swap(__float_as_uint(v), __float_as_uint(v), false, false); lo = __uint_as_float(rr[0]); hi_ = __uint_as_float(rr[1]); }
template <int MODE  , int VAR = 0  >
__device__ __forceinline__ void attn_unit(const Frame& F, int b, int h, int qb, unsigned* qctr, unsigned& nxt) {
    const int lane = F.lane, wid = F.wave, r32 = lane & 31, hi = lane >> 5;
    const bf16_t* P = (const bf16_t*)(F.ws + WS_P); const bf16_t* MKV = (const bf16_t*)(F.ws + WS_MKV); bf16_t* Y = (bf16_t*)(F.ws + WS_Y);
    const size_t tok0 = (size_t)b * SEQ + (size_t)qb * 256;
    const bf16_t* Qp = P + tok0 * INC + (MODE ? C_Q : C_MQ) + h * 64;
    const bf16_t* Kb = MODE ? P + (size_t)b * SEQ * INC + C_K + h * 64 : MKV + (size_t)b * NMEM * 512 + h * 64;
    const bf16_t* Vb = MODE ? P + (size_t)b * SEQ * INC + C_V + h * 64 : MKV + (size_t)b * NMEM * 512 + 256 + h * 64;
    const int pkv = MODE ? INC : 512;
    const int nt = MODE ? 4 + 4 * qb : 4;
    LAS unsigned char* lds = F.lds;
    const LAS float* ETAB = (const LAS float*)(lds + AT_LUT) + h * 640;
    auto tile_row = [&](int t) -> int { return MODE ? (t < 4 ? qb * 256 + 64 * t : 64 * (t - 4)) : 64 * t; };
    bf16x8 qf[4];
#pragma unroll
    for (int s = 0; s < 4; ++s) qf[s] = *(const bf16x8*)(Qp + (size_t)(32 * wid + r32) * INC + 16 * s + 8 * hi);
    u32x4 kreg, vreg, kr0, vr0, kr1, vr1;
    const int skey = 8 * wid + (lane >> 3), sseg = lane & 7;
    auto gload = [&](int t) { const size_t ro = (size_t)(tile_row(t) + skey) * pkv + 8 * sseg; kreg = *(const u32x4*)(Kb + ro); vreg = *(const u32x4*)(Vb + ro); };
    LAS unsigned char* const pKW = lds + AT_KB + skey * 144 + 16 * sseg;
    LAS unsigned char* const pVW = lds + AT_VB + ((8 * sseg) * 72 + (skey ^ (4 * sseg))) * 2;
    auto lwrite_r = [&](auto bc, const u32x4& kq, const u32x4& vq) { constexpr int BW = decltype(bc)::v;
        *(LAS u32x4*)(pKW + BW * 9216) = kq;
        LAS unsigned short* vt = (LAS unsigned short*)(pVW + BW * 9216);
        vt[0 * 72] = (unsigned short)(vq.x & 0xffff); vt[1 * 72] = (unsigned short)(vq.x >> 16); vt[2 * 72] = (unsigned short)(vq.y & 0xffff); vt[3 * 72] = (unsigned short)(vq.y >> 16);
        vt[4 * 72] = (unsigned short)(vq.z & 0xffff); vt[5 * 72] = (unsigned short)(vq.z >> 16); vt[6 * 72] = (unsigned short)(vq.w & 0xffff); vt[7 * 72] = (unsigned short)(vq.w >> 16); };
    { const size_t r0 = (size_t)(tile_row(0) + skey) * pkv + 8 * sseg, r1 = (size_t)(tile_row(1) + skey) * pkv + 8 * sseg;
      kr0 = *(const u32x4*)(Kb + r0); vr0 = *(const u32x4*)(Vb + r0); kr1 = *(const u32x4*)(Kb + r1); vr1 = *(const u32x4*)(Vb + r1); }
    gload(2);
    unsigned selmask = 0xffu;
    if (MODE) {
        const float* KM = (const float*)(F.ws + WS_KM) + (size_t)(b * 8) * 384 + h * 64;
        float kmv = 0.f;
        if (F.tid >= 64) kmv = KM[((F.tid - 64) >> 6) * 384 + (F.tid & 63)];
        if (F.tid >= 64) ((LAS float*)(lds + AT_KM))[F.tid - 64] = kmv;
    }
    lwrite_r(ATIC<0>{}, kr0, vr0); lwrite_r(ATIC<1>{}, kr1, vr1);
    __syncthreads();
    if (MODE) {
        if (qb >= 4) {
            const LAS float* KMs = (const LAS float*)(lds + AT_KM);
            float v1 = -INFINITY, v2 = -INFINITY, v3 = -INFINITY; int i1 = 0, i2 = 0, i3 = 0;
#pragma unroll 1
            for (int n = 0; n < qb; ++n) { float g = 0.f;
#pragma unroll
                for (int s = 0; s < 4; ++s) { const f32x4 k0 = *(const LAS f32x4*)(KMs + n * 64 + 16 * s + 8 * hi), k1 = *(const LAS f32x4*)(KMs + n * 64 + 16 * s + 8 * hi + 4);
                    g += bf2f((unsigned short)qf[s][0]) * k0[0] + bf2f((unsigned short)qf[s][1]) * k0[1] + bf2f((unsigned short)qf[s][2]) * k0[2] + bf2f((unsigned short)qf[s][3]) * k0[3]
                       + bf2f((unsigned short)qf[s][4]) * k1[0] + bf2f((unsigned short)qf[s][5]) * k1[1] + bf2f((unsigned short)qf[s][6]) * k1[2] + bf2f((unsigned short)qf[s][7]) * k1[3]; }
                { float x0, x1; half_swap(g, x0, x1); g = x0 + x1; }
                const bool b1 = g > v1, b2 = g > v2, b3 = g > v3;
                v3 = b2 ? v2 : (b3 ? g : v3); i3 = b2 ? i2 : (b3 ? n : i3);
                v2 = b1 ? v1 : (b2 ? g : v2); i2 = b1 ? i1 : (b2 ? n : i2);
                v1 = b1 ? g : v1; i1 = b1 ? n : i1; }
            selmask = (1u << i1) | (1u << i2) | (1u << i3);
        } else selmask = (1u << qb) - 1u;
    }
    bool started = false;
    float m_run = 0.f, l_run = 0.f;
    f32x16 o0 = {}, o1 = {};
    const int qrel = 32 * wid + r32;
    constexpr float SC = 0.125f * LOG2E;
    f32x16 s0 = {}, s1 = {}, z0 = {}, z1 = {};
    const LAS unsigned char* const pKR = lds + AT_KB + r32 * 144 + 16 * hi;
    const int swa = 4 * ((r32 >> 3) & 7), swb = 4 * (((32 + r32) >> 3) & 7);
    const LAS unsigned char* pVA[4]; const LAS unsigned char* pVQ[4];
#pragma unroll
    for (int q = 0; q < 4; ++q) { pVA[q] = lds + AT_VB + r32 * 144 + 2 * (((8 * q) ^ (swa & 24)) + ((4 * hi) ^ (swa & 4)));
                                  pVQ[q] = lds + AT_VB + (32 + r32) * 144 + 2 * (((8 * q) ^ (swb & 24)) + ((4 * hi) ^ (swb & 4))); }
#pragma unroll
    for (int s = 0; s < 4; ++s) { const bf16x8 k0 = *(const LAS bf16x8*)(pKR + 32 * s), k1 = *(const LAS bf16x8*)(pKR + 4608 + 32 * s);
        s0 = __builtin_amdgcn_mfma_f32_32x32x16_bf16(k0, qf[s], s0, 0, 0, 0); s1 = __builtin_amdgcn_mfma_f32_32x32x16_bf16(k1, qf[s], s1, 0, 0, 0); }
#define AT_CHUNK(i) { f32x2 a_ = (f32x2){S0[2 * (i)], S0[2 * (i) + 1]}, c_ = (f32x2){S1[2 * (i)], S1[2 * (i) + 1]}; \
                if (VAR != 5) { a_.x = __builtin_amdgcn_exp2f(a_.x); a_.y = __builtin_amdgcn_exp2f(a_.y); c_.x = __builtin_amdgcn_exp2f(c_.x); c_.y = __builtin_amdgcn_exp2f(c_.y); } \
                ps2 += a_; ps2 += c_; pa[i] = pk2(a_.x, a_.y); pc[i] = pk2(c_.x, c_.y); asm volatile("" : "+v"(pa[i]), "+v"(pc[i])); }
#define AT_VREAD(u, sp) { constexpr int vo_ = BC * 9216 + 64 * (u); \
                const u32x2 a0_ = *(const LAS u32x2*)(pVA[2 * (sp)] + vo_), a1_ = *(const LAS u32x2*)(pVA[2 * (sp) + 1] + vo_); \
                const u32x2 b0_ = *(const LAS u32x2*)(pVQ[2 * (sp)] + vo_), b1_ = *(const LAS u32x2*)(pVQ[2 * (sp) + 1] + vo_); \
                va[u][sp] = (u32x4){a0_.x, a0_.y, a1_.x, a1_.y}; vq[u][sp] = (u32x4){b0_.x, b0_.y, b1_.x, b1_.y}; }
#define AT_SB() __builtin_amdgcn_sched_barrier(0)
#define AT_MF(a, b, c) do { if (VAR != 4) c = __builtin_amdgcn_mfma_f32_32x32x16_bf16(a, b, c, 0, 0, 0); else asm volatile("" : "+v"(c) : "v"(a), "v"(b)); } while (0)
    auto tile_step = [&](auto bc, f32x16& S0, f32x16& S1, f32x16& N0, f32x16& N1, const int t) __attribute__((always_inline)) {
        constexpr int BC = decltype(bc)::v, BN = (BC + 1) & 3, BS = (BC + 2) & 3;
        int nblk = 0, jb = t;
        if (MODE && t >= 4) { nblk = (t - 4) >> 2; jb = (t - 4) & 3; }
        if (VAR != 8 && VAR != 9) {
            bf16x8 kf[8];
#pragma unroll
            for (int s = 0; s < 4; ++s) { kf[2 * s] = *(const LAS bf16x8*)(pKR + BN * 9216 + 32 * s); kf[2 * s + 1] = *(const LAS bf16x8*)(pKR + BN * 9216 + 4608 + 32 * s); }
            if (MODE && (t < 4 || (nblk == qb - 1 && jb >= 2))) { const LAS float* Ep = ETAB + (t < 4 ? 383 - qrel + 64 * t + 4 * hi : 127 - qrel + 64 * jb + 4 * hi);
#pragma unroll
                for (int r = 0; r < 16; ++r) { const int cr = (r & 3) + 8 * (r >> 2); S0[r] += Ep[cr]; S1[r] += Ep[cr + 32]; } }
            float mx;
            { float a = fmaxf(fmaxf(S0[0], S0[1]), S1[0]), b = fmaxf(fmaxf(S0[2], S0[3]), S1[1]); a = fmaxf(fmaxf(a, S1[2]), S1[3]);
#pragma unroll
              for (int r = 4; r < 16; r += 4) { a = fmaxf(fmaxf(a, S0[r]), S0[r + 1]); b = fmaxf(fmaxf(b, S0[r + 2]), S0[r + 3]); a = fmaxf(fmaxf(a, S1[r]), S1[r + 1]); b = fmaxf(fmaxf(b, S1[r + 2]), S1[r + 3]); }
              float x0, x1; half_swap(__builtin_fmaxf(a, b), x0, x1); mx = __builtin_fmaxf(x0, x1); }
            const bool live = mx > -INFINITY;
            const bool need = (mx > AT_THR) || (live && !started);
            started = started || live;
            if (__builtin_amdgcn_ballot_w64(need) != 0ull) { const float dl = need ? mx : 0.f; const float al = __builtin_amdgcn_exp2f(-dl);
                m_run += dl; l_run *= al;
#pragma unroll
                for (int r = 0; r < 16; ++r) { o0[r] *= al; o1[r] *= al; S0[r] -= dl; S1[r] -= dl; } }
            f32x2 ps2 = {0.f, 0.f};
            unsigned pa[8], pc[8];
            u32x4 va[2][2], vq[2][2];
            { float ci = -m_run; if (MODE && t >= 3) ci = ((selmask >> ((t - 3) >> 2)) & 1u) ? ci : -INFINITY;
#pragma unroll
              for (int r = 0; r < 16; ++r) { N0[r] = ci; N1[r] = ci; } }
            AT_SB();
            AT_MF(kf[0], qf[0], N0); AT_MF(kf[1], qf[0], N1); AT_CHUNK(0); AT_SB();
            AT_MF(kf[2], qf[1], N0); AT_MF(kf[3], qf[1], N1); AT_CHUNK(1); AT_SB();
            AT_MF(kf[4], qf[2], N0); AT_MF(kf[5], qf[2], N1); AT_CHUNK(2); AT_VREAD(0, 0); AT_SB();
            AT_MF(kf[6], qf[3], N0); AT_MF(kf[7], qf[3], N1); AT_CHUNK(3); AT_VREAD(1, 0); AT_SB();
            { const bf16x8 p00 = __builtin_bit_cast(bf16x8, (u32x4){pa[0], pa[1], pa[2], pa[3]}), p10 = __builtin_bit_cast(bf16x8, (u32x4){pc[0], pc[1], pc[2], pc[3]});
              AT_MF(__builtin_bit_cast(bf16x8, va[0][0]), p00, o0); AT_CHUNK(4); AT_SB();
              AT_MF(__builtin_bit_cast(bf16x8, vq[0][0]), p00, o1); AT_CHUNK(5); AT_VREAD(0, 1); AT_SB();
              AT_MF(__builtin_bit_cast(bf16x8, va[1][0]), p10, o0); AT_CHUNK(6); AT_VREAD(1, 1); AT_SB();
              AT_MF(__builtin_bit_cast(bf16x8, vq[1][0]), p10, o1); AT_CHUNK(7); AT_SB(); }
            { const bf16x8 p01 = __builtin_bit_cast(bf16x8, (u32x4){pa[4], pa[5], pa[6], pa[7]}), p11 = __builtin_bit_cast(bf16x8, (u32x4){pc[4], pc[5], pc[6], pc[7]});
              AT_MF(__builtin_bit_cast(bf16x8, va[0][1]), p01, o0); AT_MF(__builtin_bit_cast(bf16x8, vq[0][1]), p01, o1);
              AT_MF(__builtin_bit_cast(bf16x8, va[1][1]), p11, o0); AT_MF(__builtin_bit_cast(bf16x8, vq[1][1]), p11, o1); }
            l_run += ps2.x + ps2.y;
        }
        if (VAR != 2 && VAR != 8) { if (t + 2 < nt) lwrite_r(ATIC<BS>{}, kreg, vreg);
            if (t + 3 < nt) gload(t + 3); }
        if (VAR != 3) __syncthreads();
    };
#pragma unroll 1
    for (int t = 0; t < nt; t += 4) {
        if (t == nt - 4 && F.tid == 0) nxt = atomicAdd(qctr, 1u);
        tile_step(ATIC<0>{}, s0, s1, z0, z1, t); tile_step(ATIC<1>{}, z0, z1, s0, s1, t + 1);
        tile_step(ATIC<2>{}, s0, s1, z0, z1, t + 2); tile_step(ATIC<3>{}, z0, z1, s0, s1, t + 3);
    }
#undef AT_CHUNK
#undef AT_VREAD
#undef AT_SB
#undef AT_MF
    { float x0, x1; half_swap(l_run, x0, x1); l_run = x0 + x1; }
    const float inv = 1.0f / l_run;
    bf16_t* yp = Y + (tok0 + 32 * wid + r32) * DM + (MODE ? 0 : 768) + h * 64;
#pragma unroll
    for (int g = 0; g < 4; ++g) { u32x2 w0, w1; w0.x = pk2(o0[4 * g] * inv, o0[4 * g + 1] * inv); w0.y = pk2(o0[4 * g + 2] * inv, o0[4 * g + 3] * inv);
        w1.x = pk2(o1[4 * g] * inv, o1[4 * g + 1] * inv); w1.y = pk2(o1[4 * g + 2] * inv, o1[4 * g + 3] * inv);
        if (VAR == 0) { *(u32x2*)(yp + 8 * g + 4 * hi) = w0; *(u32x2*)(yp + 32 + 8 * g + 4 * hi) = w1; } else asm volatile("" :: "v"(w0), "v"(w1)); }
}

template <int VAR = 0>
__device__ __forceinline__ void attention_phase(const Frame& F, int qslot) {
    LAS int* uslot = (LAS int*)(F.lds + AT_UNIT);
    { const float* rb = F.in[I_RELB]; LAS float* ET = (LAS float*)(F.lds + AT_LUT);
#pragma unroll 1
      for (int i = F.tid; i < 6 * 640; i += NTHREADS) { const int h = i / 640, d = 383 - (i - h * 640); const int n = d > 127 ? 127 : d; int bk = n;
          if (n >= 16) { bk = 16 + (int)(__logf((float)n * (1.0f / 16.0f)) / __logf(8.0f) * 16.0f); bk = bk > 31 ? 31 : bk; }
          ET[i] = d < 0 ? -INFINITY : (rb[(bk < 0 ? 0 : bk) * 6 + h] - rb[31 * 6 + h]) * LOG2E; } }
    unsigned* qctr = F.ctl() + qslot;
    unsigned nxt = 0u;
    if (F.tid == 0) nxt = atomicAdd(qctr, 1u);
#pragma unroll 1
    for (int it = 0;; ++it) {
        if (F.tid == 0) uslot[it & 1] = (int)nxt;
        __syncthreads();
        const int u = uslot[it & 1];
        if (u >= 640) break;
        if (u < 384) { const int qb = 7 - u / 48, bh = u % 48; attn_unit<1, VAR>(F, bh / 6, bh % 6, qb, qctr, nxt); }
        else { const int m = u - 384; attn_unit<0, VAR>(F, m >> 5, (m >> 3) & 3, m & 7, qctr, nxt); }
    }
}
constexpr int RS = 144;
constexpr int L_AT = 0, L_BT = 9216, L_KT = 18432, L_RT = 27648, L_BTT = 36864, L_CUM = 49152, L_AAK = 49152, L_ARB = 58368, L_TOT = 65536, L_KTT = 67584, L_VT = 76800,
              L_RHS = 86016, L_AABS = 118784, L_ARK = 135168, L_WAT = 86016, L_UVT = 95232, L_GC = 46080;
constexpr int L_LW = 0, L_LA = 16384, L_LG = 32768;
constexpr int RWU_MC = 0, RWU_QC = 8192, RWU_G1 = 16384, RWU_VB = 24576, RWU_NC = 32768, RWU_OL = 40960, RWU_BYTES = 49152;

__device__ __forceinline__ void mm_tile(f32x16& acc, const LAS unsigned char* Ab, int arow0, const LAS unsigned char* Bb, int brow0, int r32, int hi) {
#pragma unroll
    for (int s = 0; s < 4; ++s) { const bf16x8 a = *(const LAS bf16x8*)(Ab + (arow0 + r32) * RS + (16 * s + 8 * hi) * 2), b = *(const LAS bf16x8*)(Bb + (brow0 + r32) * RS + (16 * s + 8 * hi) * 2);
        acc = __builtin_amdgcn_mfma_f32_32x32x16_bf16(a, b, acc, 0, 0, 0); }
}
__device__ __forceinline__ float fast_tanh(float x) { const float e = __expf(2.0f * x); return 1.0f - 2.0f * __builtin_amdgcn_rcpf(e + 1.0f); }
__device__ __forceinline__ float fast_sigmoid(float x) { return __builtin_amdgcn_rcpf(1.0f + __expf(-x)); }
__device__ __forceinline__ void unpack8(const u32x4 w, float (&f)[8]) { f[0] = bflo(w.x); f[1] = bfhi(w.x); f[2] = bflo(w.y); f[3] = bfhi(w.y); f[4] = bflo(w.z); f[5] = bfhi(w.z); f[6] = bflo(w.w); f[7] = bfhi(w.w); }
__device__ __forceinline__ u32x4 pack8(const float (&f)[8]) { u32x4 w; w.x = pk2(f[0], f[1]); w.y = pk2(f[2], f[3]); w.z = pk2(f[4], f[5]); w.w = pk2(f[6], f[7]); return w; }

__device__ __forceinline__ void shifted8(const bf16_t* P, const float* mu, size_t tok, bool first, int col, float (&o)[8]) {
    float c[8], p[8]; unpack8(*(const u32x4*)(P + tok * INC + C_RW + col), c);
    if (!first) unpack8(*(const u32x4*)(P + (tok - 1) * INC + C_RW + col), p); else {
#pragma unroll
        for (int e = 0; e < 8; ++e) p[e] = 0.f; }
    const f32x4 m0 = *(const f32x4*)(mu + col), m1 = *(const f32x4*)(mu + col + 4);
#pragma unroll
    for (int e = 0; e < 8; ++e) o[e] = c[e] + (p[e] - c[e]) * (e < 4 ? m0[e] : m1[e - 4]);
}

struct Raw2 { u32x4 c, p; };
__device__ __forceinline__ Raw2 raw8(const bf16_t* P, size_t tok, bool first, int col) { Raw2 r; r.c = *(const u32x4*)(P + tok * INC + C_RW + col); r.p = first ? (u32x4){0u, 0u, 0u, 0u} : *(const u32x4*)(P + (tok - 1) * INC + C_RW + col); return r; }
__device__ __forceinline__ void mix8(const Raw2& r, const float* mu, int col, float (&o)[8]) {
    float c[8], p[8]; unpack8(r.c, c); unpack8(r.p, p);
    const f32x4 m0 = *(const f32x4*)(mu + col), m1 = *(const f32x4*)(mu + col + 4);
#pragma unroll
    for (int e = 0; e < 8; ++e) o[e] = c[e] + (p[e] - c[e]) * (e < 4 ? m0[e] : m1[e - 4]);
}
template <int QS> __device__ __forceinline__ float quad_bcast(float v) {
    return __builtin_bit_cast(float, __builtin_amdgcn_mov_dpp(__builtin_bit_cast(int, v), QS * 0x55, 0xf, 0xf, true));
}
template <int S> struct SolveStep {
    static __device__ __forceinline__ void load(const LAS float* Aq, f32x4 (&a)[4]) { constexpr int ms = S >> 2; const LAS float* row = Aq + S * 64;
#pragma unroll
        for (int m4 = ms >> 2; m4 < 4; ++m4) a[m4] = *(const LAS f32x4*)(row + 4 * m4); }
    static __device__ __forceinline__ void run(float (&acc)[16], const LAS float* Aq  , const f32x4 (&a0)[4], const f32x4 (&a1)[4]) {
        constexpr int ms = S >> 2;
        f32x4 a2[4];
        if constexpr (S + 2 < 64) SolveStep<S + 2>::load(Aq, a2);
        const float xs = quad_bcast<S & 3>(acc[ms]);
#pragma unroll
        for (int m4 = ms >> 2; m4 < 4; ++m4) {
#pragma unroll
            for (int e = 0; e < 4; ++e) if (4 * m4 + e >= ms) acc[4 * m4 + e] += a0[m4][e] * xs; }
        if constexpr (S + 1 < 64) SolveStep<S + 1>::run(acc, Aq, a1, a2);
    }
};

__device__ __forceinline__ void lora_frags(const Frame& F, int h, int w, int r32, int hi, bf16x8 (&wf)[8]) {
    const bf16_t* WU = (const bf16_t*)(F.ws + WS_LORA); const bf16_t* AU = WU + 384 * 64; const bf16_t* GU = WU + 2 * 384 * 64;
    const int jrow = h * 64 + 32 * (w & 1) + r32;
    if (w < 4) {
#pragma unroll
        for (int s = 0; s < 4; ++s) { wf[s] = *(const bf16x8*)(WU + (size_t)jrow * 64 + 16 * s + 8 * hi); wf[4 + s] = *(const bf16x8*)(AU + (size_t)jrow * 64 + 16 * s + 8 * hi); }
    } else {
#pragma unroll
        for (int s = 0; s < 8; ++s) wf[s] = *(const bf16x8*)(GU + (size_t)jrow * 128 + 16 * s + 8 * hi);
    }
}
template <int CUT = 7> __device__ __forceinline__ void rwkv_chunk_unit(const Frame& F, int b, int h, int c, const bf16x8 (&fA)[8], Raw2 (&rw)[3], bf16x8 (&wf)[8]) {
    int tid = F.tid; asm volatile("" : "+v"(tid));
    const int lane = tid & 63, w = F.wave; int r32 = lane & 31, hi = lane >> 5;
    LAS unsigned char* lds = F.lds;
    const bf16_t* P = (const bf16_t*)(F.ws + WS_P); const float* mu = F.in[I_MU];
    const size_t T0 = (size_t)b * SEQ + (size_t)c * 64;
    unsigned char* ug = F.ws + WS_RW + (size_t)((b * 6 + h) * 32 + c) * RWU_BYTES;
    f32x4 pm[3][2], pw0[2], pa0[2], pkk[2], pka[2], prk[2], pgg[2], pgb[2];
    { const int hj_ = h * 64 + (tid & 7) * 8;
#pragma unroll
      for (int q = 0; q < 2; ++q) { pm[0][q] = *(const f32x4*)(mu + RW_R + hj_ + 4 * q); pm[1][q] = *(const f32x4*)(mu + RW_K + hj_ + 4 * q); pm[2][q] = *(const f32x4*)(mu + RW_V + hj_ + 4 * q);
          pw0[q] = *(const f32x4*)(F.in[I_W0] + hj_ + 4 * q); pa0[q] = *(const f32x4*)(F.in[I_A0] + hj_ + 4 * q); pkk[q] = *(const f32x4*)(F.in[I_KK] + hj_ + 4 * q); pka[q] = *(const f32x4*)(F.in[I_KA] + hj_ + 4 * q);
          prk[q] = *(const f32x4*)(F.in[I_RK] + hj_ + 4 * q); pgg[q] = *(const f32x4*)(F.in[I_GNG] + hj_ + 4 * q); pgb[q] = *(const f32x4*)(F.in[I_GNB] + hj_ + 4 * q); } }
    {
        const int rt = (w & 3) >> 1, ct = w & 1;
        if (w < 4) {
            f32x16 aw = {}, aa = {};
#pragma unroll
            for (int s = 0; s < 4; ++s) {
                aw = __builtin_amdgcn_mfma_f32_32x32x16_bf16(fA[s], wf[s], aw, 0, 0, 0); aa = __builtin_amdgcn_mfma_f32_32x32x16_bf16(fA[4 + s], wf[4 + s], aa, 0, 0, 0); }
#pragma unroll
            for (int r = 0; r < 16; ++r) { const int o = (32 * rt + crow(r, hi)) * 64 + 32 * ct + r32; ((LAS float*)(lds + L_LW))[o] = aw[r]; ((LAS float*)(lds + L_LA))[o] = aa[r]; }
        } else {
            f32x16 ag = {};
#pragma unroll
            for (int s = 0; s < 8; ++s) ag = __builtin_amdgcn_mfma_f32_32x32x16_bf16(fA[s], wf[s], ag, 0, 0, 0);
#pragma unroll
            for (int r = 0; r < 16; ++r) ((LAS float*)(lds + L_LG))[(32 * rt + crow(r, hi)) * 64 + 32 * ct + r32] = ag[r];
        }
        if (h < 5) lora_frags(F, h + 1, w, r32, hi, wf);
    }
    __syncthreads();
    if (CUT <= 1) return;
    const int t = tid >> 3, j0 = (tid & 7) * 8, hj = h * 64 + j0;
    float rr[8], km[8], vv[8], av[8], bv[8], lw[8], gg[8], bonus;
    {
        const size_t tok = T0 + t; const bool first = (c == 0 && t == 0);
        float kx[8];
        { float c8[8], p8[8];
#define MIXP(RAW, M, OUT) unpack8(RAW.c, c8); unpack8(RAW.p, p8); _Pragma("unroll") for (int e = 0; e < 8; ++e) OUT[e] = c8[e] + (p8[e] - c8[e]) * M[e >> 2][e & 3];
          MIXP(rw[0], pm[0], rr) MIXP(rw[1], pm[1], kx) MIXP(rw[2], pm[2], vv)
#undef MIXP
        }
        if (h < 5) { rw[0] = raw8(P, tok, first, RW_R + hj + 64); rw[1] = raw8(P, tok, first, RW_K + hj + 64); rw[2] = raw8(P, tok, first, RW_V + hj + 64); }
        float asg[8], kk[8], ss = 0.f, bs = 0.f;
#pragma unroll
        for (int e = 0; e < 8; ++e) {
            const float z = -(pw0[e >> 2][e & 3] + ((const LAS float*)(lds + L_LW))[t * 64 + j0 + e]);
            const float sp = fmaxf(z, 0.f) + __logf(1.0f + __expf(-fabsf(z)));
            lw[e] = -__expf(-sp - 0.5f);
            asg[e] = fast_sigmoid(pa0[e >> 2][e & 3] + ((const LAS float*)(lds + L_LA))[t * 64 + j0 + e]);
            gg[e] = ((const LAS float*)(lds + L_LG))[t * 64 + j0 + e];
            kk[e] = kx[e] * pkk[e >> 2][e & 3]; ss += kk[e] * kk[e];
            km[e] = kx[e] * (1.0f + (asg[e] - 1.0f) * pka[e >> 2][e & 3]);
            bs += rr[e] * km[e] * prk[e >> 2][e & 3];
        }
        ss += __shfl_xor(ss, 1); ss += __shfl_xor(ss, 2); ss += __shfl_xor(ss, 4);
        bs += __shfl_xor(bs, 1); bs += __shfl_xor(bs, 2); bs += __shfl_xor(bs, 4);
        bonus = bs;
        const float inv = 1.0f / fmaxf(sqrtf(ss), 1e-12f);
#pragma unroll
        for (int e = 0; e < 8; ++e) { const float kn = kk[e] * inv; av[e] = -kn; bv[e] = kn * asg[e]; }
    }
    __syncthreads();
    if (CUT == 2) { asm volatile("" :: "v"(rr[0] + km[1] + vv[2] + av[3] + bv[4] + lw[5] + gg[6] + bonus)); return; }
    float Li[8];
    {
        LAS float* tot = (LAS float*)(lds + L_TOT);
#pragma unroll
        for (int e = 0; e < 8; ++e) { float x = lw[e];
#pragma unroll
            for (int off = 8; off < 64; off <<= 1) { const float y = __shfl_up(x, off); x += (lane >= off) ? y : 0.f; }
            Li[e] = x; }
        if ((lane >> 3) == 7) {
#pragma unroll
            for (int e = 0; e < 8; ++e) tot[w * 64 + j0 + e] = Li[e]; }
        __syncthreads();
#pragma unroll
        for (int q = 0; q < 7; ++q) if (q < w) {
#pragma unroll
            for (int e = 0; e < 8; ++e) Li[e] += tot[q * 64 + j0 + e]; }
    }
    {
        float At[8], Bt[8], Kt[8], Rt[8];
#pragma unroll
        for (int e = 0; e < 8; ++e) { const float gi = __expf(-Li[e]); At[e] = av[e] * __expf(Li[e] - lw[e]); Bt[e] = bv[e] * gi; Kt[e] = km[e] * gi; Rt[e] = rr[e] * __expf(Li[e]); }
        if (t == 63) {
#pragma unroll
            for (int e = 0; e < 8; ++e) ((LAS float*)(lds + L_GC))[j0 + e] = __expf(Li[e]); }
        *(LAS u32x4*)(lds + L_AT + t * RS + j0 * 2) = pack8(At); *(LAS u32x4*)(lds + L_BT + t * RS + j0 * 2) = pack8(Bt);
        *(LAS u32x4*)(lds + L_KT + t * RS + j0 * 2) = pack8(Kt); *(LAS u32x4*)(lds + L_RT + t * RS + j0 * 2) = pack8(Rt);
#pragma unroll
        for (int e = 0; e < 8; ++e) { *(LAS unsigned short*)(lds + L_BTT + (j0 + e) * RS + 2 * t) = (unsigned short)f2bf(Bt[e]); *(LAS unsigned short*)(lds + L_KTT + (j0 + e) * RS + 2 * t) = (unsigned short)f2bf(Kt[e]);
            *(LAS unsigned short*)(lds + L_VT + (j0 + e) * RS + 2 * t) = (unsigned short)f2bf(vv[e]); }
        { LAS float* rhs = (LAS float*)(lds + L_RHS) + t * 128 + j0; *(LAS f32x4*)rhs = (f32x4){At[0], At[1], At[2], At[3]}; *(LAS f32x4*)(rhs + 4) = (f32x4){At[4], At[5], At[6], At[7]}; }
        float g1[8], vb[8];
#pragma unroll
        for (int e = 0; e < 8; ++e) { g1[e] = pgg[e >> 2][e & 3] * gg[e]; vb[e] = (pgb[e >> 2][e & 3] + bonus * vv[e]) * gg[e]; }
        const int it = j0 >> 5, tt = t >> 5, rb = 4 * ((j0 >> 3) & 3);
        bf16_t* g1p = (bf16_t*)(ug + RWU_G1) + ((size_t)((it * 2 + tt) * 64 + (t & 31)) * 16 + rb); bf16_t* vbp = (bf16_t*)(ug + RWU_VB) + ((size_t)((it * 2 + tt) * 64 + (t & 31)) * 16 + rb);
        { u32x2 x; x.x = pk2(g1[0], g1[1]); x.y = pk2(g1[2], g1[3]); *(u32x2*)g1p = x; x.x = pk2(g1[4], g1[5]); x.y = pk2(g1[6], g1[7]); *(u32x2*)(g1p + 32 * 16) = x; }
        { u32x2 x; x.x = pk2(vb[0], vb[1]); x.y = pk2(vb[2], vb[3]); *(u32x2*)vbp = x; x.x = pk2(vb[4], vb[5]); x.y = pk2(vb[6], vb[7]); *(u32x2*)(vbp + 32 * 16) = x; }
    }
    __syncthreads();
    if (CUT <= 3) return;
    asm volatile("" : "+v"(r32), "+v"(hi));
    {
        const int p = w >> 1, ct = w & 1; const LAS unsigned char* Ab = lds + ((p & 1) ? L_KT : L_BT); const LAS unsigned char* Bb = lds + ((p >> 1) ? L_RT : L_AT);
#pragma unroll
        for (int rs_ = 0; rs_ < 2; ++rs_) { f32x16 d = {}; mm_tile(d, Ab, 32 * rs_, Bb, 32 * ct, r32, hi);
            const int tq = 32 * ct + r32;
#pragma unroll
            for (int r = 0; r < 16; ++r) { const int s = 32 * rs_ + crow(r, hi); const bool keep = (p >> 1) ? (s <= tq) : (s < tq); d[r] = keep ? d[r] : 0.f; }
            if (p == 0) {
#pragma unroll
                for (int r = 0; r < 16; ++r) { const int s = 32 * rs_ + crow(r, hi); ((LAS float*)(lds + L_AABS))[(s * 4 + (tq & 3)) * 16 + (tq >> 2)] = d[r]; }
            } else { LAS unsigned char* dst = lds + (p == 1 ? L_AAK : p == 2 ? L_ARB : L_ARK) + tq * RS;
#pragma unroll
                for (int g = 0; g < 4; ++g) { u32x2 x; x.x = pk2(d[4 * g], d[4 * g + 1]); x.y = pk2(d[4 * g + 2], d[4 * g + 3]); *(LAS u32x2*)(dst + (32 * rs_ + 8 * g + 4 * hi) * 2) = x; } }
        }
    }
    __syncthreads();
    asm volatile("" : "+v"(r32), "+v"(hi));
    if (w < 4) {
        const int rt = w >> 1, ct = w & 1; f32x16 d = {}; mm_tile(d, lds + L_AAK, 32 * rt, lds + L_VT, 32 * ct, r32, hi);
#pragma unroll
        for (int r = 0; r < 16; ++r) ((LAS float*)(lds + L_RHS))[(32 * rt + crow(r, hi)) * 128 + 64 + 32 * ct + r32] = d[r];
    }
    __syncthreads();
    if (CUT <= 5) return;
    {
        int l2 = lane; asm volatile("" : "+v"(l2)); const int col = 16 * w + (l2 >> 2), q = l2 & 3; float acc[16];
#pragma unroll
        for (int m = 0; m < 16; ++m) acc[m] = ((const LAS float*)(lds + L_RHS))[(4 * m + q) * 128 + col];
        __syncthreads();
        { const LAS float* Aq = (const LAS float*)(lds + L_AABS) + q * 16; f32x4 a0[4], a1[4]; SolveStep<0>::load(Aq, a0); SolveStep<1>::load(Aq, a1); SolveStep<0>::run(acc, Aq, a0, a1); }
        LAS unsigned char* dst = lds + (col < 64 ? L_WAT + col * RS : L_UVT + (col - 64) * RS);
#pragma unroll
        for (int m = 0; m < 16; ++m) *(LAS unsigned short*)(dst + (4 * m + q) * 2) = (unsigned short)f2bf(acc[m]);
    }
    __syncthreads();
    if (CUT <= 6) return;
    asm volatile("" : "+v"(r32), "+v"(hi));
    {
        const int ta = (w & 3) >> 1, tb = w & 1; const int tile = ta * 2 + tb;
        const LAS float* gc = (const LAS float*)(lds + L_GC);
        if (w < 4) {
            f32x16 d = {}; mm_tile(d, lds + L_WAT, 32 * ta, lds + L_BTT, 32 * tb, r32, hi);
            const float gcl = gc[32 * tb + r32]; float f[16];
#pragma unroll
            for (int r = 0; r < 16; ++r) f[r] = (d[r] + ((32 * ta + crow(r, hi)) == (32 * tb + r32) ? 1.0f : 0.f)) * gcl;
            u32x4 x0, x1; x0.x = pk2(f[0], f[1]); x0.y = pk2(f[2], f[3]); x0.z = pk2(f[4], f[5]); x0.w = pk2(f[6], f[7]); x1.x = pk2(f[8], f[9]); x1.y = pk2(f[10], f[11]); x1.z = pk2(f[12], f[13]); x1.w = pk2(f[14], f[15]);
            u32x4* o = (u32x4*)(ug + RWU_MC + (size_t)(tile * 64 + lane) * 32); o[0] = x0; o[1] = x1;
            f32x16 n = {}; mm_tile(n, lds + L_BTT, 32 * ta, lds + L_UVT, 32 * tb, r32, hi); mm_tile(n, lds + L_KTT, 32 * ta, lds + L_VT, 32 * tb, r32, hi);
            float nf[16];
#pragma unroll
            for (int r = 0; r < 16; ++r) nf[r] = n[r] * gc[32 * ta + crow(r, hi)];
            { u32x4 y0, y1; y0.x = pk2(nf[0], nf[1]); y0.y = pk2(nf[2], nf[3]); y0.z = pk2(nf[4], nf[5]); y0.w = pk2(nf[6], nf[7]); y1.x = pk2(nf[8], nf[9]); y1.y = pk2(nf[10], nf[11]); y1.z = pk2(nf[12], nf[13]); y1.w = pk2(nf[14], nf[15]);
              u32x4* on = (u32x4*)(ug + RWU_NC + (size_t)(tile * 64 + lane) * 32); on[0] = y0; on[1] = y1; }
        } else {
            f32x16 d = {}; mm_tile(d, lds + L_WAT, 32 * ta, lds + L_ARB, 32 * tb, r32, hi);
            float f[16];
#pragma unroll
            for (int g = 0; g < 4; ++g) { const u32x2 rv = *(const LAS u32x2*)(lds + L_RT + (32 * tb + r32) * RS + (32 * ta + 8 * g + 4 * hi) * 2);
                f[4 * g] = d[4 * g] + bflo(rv.x); f[4 * g + 1] = d[4 * g + 1] + bfhi(rv.x); f[4 * g + 2] = d[4 * g + 2] + bflo(rv.y); f[4 * g + 3] = d[4 * g + 3] + bfhi(rv.y); }
            u32x4 x0, x1; x0.x = pk2(f[0], f[1]); x0.y = pk2(f[2], f[3]); x0.z = pk2(f[4], f[5]); x0.w = pk2(f[6], f[7]); x1.x = pk2(f[8], f[9]); x1.y = pk2(f[10], f[11]); x1.z = pk2(f[12], f[13]); x1.w = pk2(f[14], f[15]);
            u32x4* o = (u32x4*)(ug + RWU_QC + (size_t)(tile * 64 + lane) * 32); o[0] = x0; o[1] = x1;
            f32x16 n = {}; mm_tile(n, lds + L_UVT, 32 * ta, lds + L_ARB, 32 * tb, r32, hi); mm_tile(n, lds + L_VT, 32 * ta, lds + L_ARK, 32 * tb, r32, hi);
            { u32x4 y0, y1; y0.x = pk2(n[0], n[1]); y0.y = pk2(n[2], n[3]); y0.z = pk2(n[4], n[5]); y0.w = pk2(n[6], n[7]); y1.x = pk2(n[8], n[9]); y1.y = pk2(n[10], n[11]); y1.z = pk2(n[12], n[13]); y1.w = pk2(n[14], n[15]);
              u32x4* on = (u32x4*)(ug + RWU_OL + (size_t)(tile * 64 + lane) * 32); on[0] = y0; on[1] = y1; }
        }
    }
    __syncthreads();
}

template <int CUT = 7> __device__ __forceinline__ void rwkv_chunk_phase(const Frame& F) {
    const bf16_t* P = (const bf16_t*)(F.ws + WS_P); const float* mu = F.in[I_MU];
    for (int su = F.bid; su < NB * 32; su += F.G) { const int b = su >> 5, c = su & 31;
        int tid = F.tid; asm volatile("" : "+v"(tid));
        const int lane = tid & 63, w = F.wave, r32 = lane & 31, hi = lane >> 5;
        const size_t T0 = (size_t)b * SEQ + (size_t)c * 64;
        bf16x8 wf[8]; lora_frags(F, 0, F.wave, F.lane & 31, F.lane >> 5, wf);
        Raw2 rw[3];
        { const int t = tid >> 3, j0 = (tid & 7) * 8; const size_t tok = T0 + t; const bool first = (c == 0 && t == 0);
          rw[0] = raw8(P, tok, first, RW_R + j0); rw[1] = raw8(P, tok, first, RW_K + j0); rw[2] = raw8(P, tok, first, RW_V + j0); }
        bf16x8 fA[8];
        { const int rt = (w & 3) >> 1; const size_t tok = T0 + 32 * rt + r32; const bool first = (c == 0 && rt == 0 && r32 == 0);
          if (w < 4) {
#pragma unroll
              for (int s = 0; s < 4; ++s) { float xw[8], xa[8]; shifted8(P, mu, tok, first, RW_XW + 16 * s + 8 * hi, xw); shifted8(P, mu, tok, first, RW_XA + 16 * s + 8 * hi, xa);
#pragma unroll
                  for (int e = 0; e < 8; ++e) xw[e] = fast_tanh(xw[e]);
                  fA[s] = __builtin_bit_cast(bf16x8, pack8(xw)); fA[4 + s] = __builtin_bit_cast(bf16x8, pack8(xa)); }
          } else {
#pragma unroll
              for (int s = 0; s < 8; ++s) { float xg[8]; shifted8(P, mu, tok, first, RW_XG + 16 * s + 8 * hi, xg);
#pragma unroll
                  for (int e = 0; e < 8; ++e) xg[e] = fast_sigmoid(xg[e]);
                  fA[s] = __builtin_bit_cast(bf16x8, pack8(xg)); }
          } }
#pragma unroll 1
        for (int h = 0; h < 6; ++h) rwkv_chunk_unit<CUT>(F, b, h, c, fA, rw, wf);
    }
}

__device__ __forceinline__ bf16x8 acc_frag(const f32x16& a, int s) {
    u32x4 x; x.x = pk2(a[8 * s], a[8 * s + 1]); x.y = pk2(a[8 * s + 2], a[8 * s + 3]); x.z = pk2(a[8 * s + 4], a[8 * s + 5]); x.w = pk2(a[8 * s + 6], a[8 * s + 7]); return __builtin_bit_cast(bf16x8, x);
}
__device__ __forceinline__ f32x16 lds_acc(const LAS unsigned char* p) { const LAS u32x4* q = (const LAS u32x4*)p; const u32x4 a = q[0], b = q[1];
    return (f32x16){bflo(a.x), bfhi(a.x), bflo(a.y), bfhi(a.y), bflo(a.z), bfhi(a.z), bflo(a.w), bfhi(a.w), bflo(b.x), bfhi(b.x), bflo(b.y), bfhi(b.y), bflo(b.z), bfhi(b.z), bflo(b.w), bfhi(b.w)}; }

constexpr int SC_HB = 2 * RWU_BYTES;
__device__ __forceinline__ void rwkv_scan(const Frame& F, int b, int h) {
    const int tid = F.tid, lane = F.lane, r32 = lane & 31, hi = lane >> 5, wv = F.wave;
    LAS unsigned char* lds = F.lds;
    const unsigned char* ug = F.ws + WS_RW + (size_t)((b * 6 + h) * 32) * RWU_BYTES;
    bf16_t* Y = (bf16_t*)(F.ws + WS_Y);
    {
        u32x4 st[6];
#pragma unroll
        for (int k = 0; k < 6; ++k) st[k] = *(const u32x4*)(ug + (size_t)(k * NTHREADS + tid) * 16);
#pragma unroll
        for (int k = 0; k < 6; ++k) *(LAS u32x4*)(lds + (k * NTHREADS + tid) * 16) = st[k];
        *(LAS u32x4*)(lds + SC_HB + tid * 16) = (u32x4){0u, 0u, 0u, 0u};
    }
    if (wv >= 3) {
        const int t5 = tid - 192; u32x4 sa[10], sb[10], sc[10], sd[10], se[10];
        const int p9 = ((t5 < 192) ? 2880 : 2560) + t5, v0 = t5 * 16, v9 = p9 * 16;
        const __amdgpu_buffer_rsrc_t rU = __builtin_amdgcn_make_buffer_rsrc((void*)ug, 0, -1, 0x00020000);
#define SC_LOAD(st, ch) do { __builtin_amdgcn_sched_barrier(0); const int so_ = ((ch) < 31 ? (ch) : 31) * RWU_BYTES; _Pragma("unroll") for (int k = 0; k < 9; ++k) st[k] = __builtin_bit_cast(u32x4, __builtin_amdgcn_raw_buffer_load_b128(rU, v0, so_ + k * 5120, 0)); st[9] = __builtin_bit_cast(u32x4, __builtin_amdgcn_raw_buffer_load_b128(rU, v9, so_, 0)); __builtin_amdgcn_sched_barrier(0); } while (0)
#define SC_WRITE(st, ch) do { LAS unsigned char* dst_ = lds + ((ch) & 1) * RWU_BYTES; _Pragma("unroll") for (int k = 0; k < 9; ++k) *(LAS u32x4*)(dst_ + (k * 320 + t5) * 16) = st[k]; *(LAS u32x4*)(dst_ + p9 * 16) = st[9]; } while (0)
        SC_LOAD(sa, 1); SC_LOAD(sb, 2); SC_LOAD(sc, 3); SC_LOAD(sd, 4); SC_LOAD(se, 5);
#pragma unroll 1
        for (int c = 0; c < 30; c += 5) {
            __syncthreads(); SC_WRITE(sa, c + 1); SC_LOAD(sa, c + 6);
            __syncthreads(); SC_WRITE(sb, c + 2); SC_LOAD(sb, c + 7);
            __syncthreads(); SC_WRITE(sc, c + 3); SC_LOAD(sc, c + 8);
            __syncthreads(); SC_WRITE(sd, c + 4); SC_LOAD(sd, c + 9);
            __syncthreads(); SC_WRITE(se, c + 5); SC_LOAD(se, c + 10);
        }
        __syncthreads(); SC_WRITE(sa, 31);
        __syncthreads();
#undef SC_LOAD
#undef SC_WRITE
    } else if (wv == 0) {
        f32x16 H[2][2];
#pragma unroll
        for (int a = 0; a < 2; ++a)
#pragma unroll
            for (int c2 = 0; c2 < 2; ++c2) H[a][c2] = (f32x16){};
#pragma unroll 1
        for (int c = 0; c < 32; ++c) {
            __syncthreads();
            const LAS unsigned char* B = lds + (c & 1) * RWU_BYTES;
            bf16x8 hb[2][2][2];
#pragma unroll
            for (int jt = 0; jt < 2; ++jt)
#pragma unroll
                for (int it = 0; it < 2; ++it)
#pragma unroll
                    for (int s = 0; s < 2; ++s) hb[jt][it][s] = acc_frag(H[jt][it], s);
#pragma unroll
            for (int rt = 0; rt < 2; ++rt)
#pragma unroll
                for (int it = 0; it < 2; ++it) { __builtin_amdgcn_sched_barrier(0); f32x16 a = lds_acc(B + RWU_NC + ((rt * 2 + it) * 64 + lane) * 32);
#pragma unroll
                    for (int kt = 0; kt < 2; ++kt)
#pragma unroll
                        for (int s = 0; s < 2; ++s) { const bf16x8 m = *(const LAS bf16x8*)(B + RWU_MC + ((kt * 2 + rt) * 64 + lane) * 32 + 16 * s);
                            a = __builtin_amdgcn_mfma_f32_32x32x16_bf16(m, hb[kt][it][s], a, 0, 0, 0); }
                    H[rt][it] = a; }
            if (c + 1 < 32) {
                LAS unsigned char* HN = lds + SC_HB + ((c + 1) & 1) * 8192;
#pragma unroll
                for (int jt = 0; jt < 2; ++jt)
#pragma unroll
                    for (int it = 0; it < 2; ++it)
#pragma unroll
                        for (int s = 0; s < 2; ++s) *(LAS bf16x8*)(HN + ((((jt * 2 + it) * 2 + s) * 64) + lane) * 16) = acc_frag(H[jt][it], s);
            }
        }
    } else {
        const int tt = wv - 1;
#pragma unroll 1
        for (int c = 0; c < 32; ++c) {
            __syncthreads();
            const LAS unsigned char* B = lds + (c & 1) * RWU_BYTES;
            const LAS unsigned char* HB = lds + SC_HB + (c & 1) * 8192;
            f32x16 O[2];
#pragma unroll
            for (int it = 0; it < 2; ++it) { f32x16 a = lds_acc(B + RWU_OL + ((it * 2 + tt) * 64 + lane) * 32);
#pragma unroll
                for (int kt = 0; kt < 2; ++kt)
#pragma unroll
                    for (int s = 0; s < 2; ++s) { const bf16x8 q = *(const LAS bf16x8*)(B + RWU_QC + ((kt * 2 + tt) * 64 + lane) * 32 + 16 * s);
                        const bf16x8 hf = *(const LAS bf16x8*)(HB + ((((kt * 2 + it) * 2 + s) * 64) + lane) * 16);
                        a = __builtin_amdgcn_mfma_f32_32x32x16_bf16(hf, q, a, 0, 0, 0); }
                O[it] = a; }
            float s1;
            { f32x2 pa = {0.f, 0.f}, pb = {0.f, 0.f};
#pragma unroll
              for (int r = 0; r < 16; r += 4) { pa += (f32x2){O[0][r], O[0][r + 1]} + (f32x2){O[1][r], O[1][r + 1]}; pb += (f32x2){O[0][r + 2], O[0][r + 3]} + (f32x2){O[1][r + 2], O[1][r + 3]}; }
              s1 = (pa.x + pa.y) + (pb.x + pb.y); }
            { float x0, x1; half_swap(s1, x0, x1); s1 = x0 + x1; } const float mean = s1 * (1.0f / 64.0f);
            float s2;
            { f32x2 pa = {0.f, 0.f}, pb = {0.f, 0.f}; const f32x2 mm = {mean, mean};
#pragma unroll
              for (int r = 0; r < 16; r += 4) { const f32x2 d0 = (f32x2){O[0][r], O[0][r + 1]} - mm, d1 = (f32x2){O[1][r], O[1][r + 1]} - mm, d2 = (f32x2){O[0][r + 2], O[0][r + 3]} - mm, d3 = (f32x2){O[1][r + 2], O[1][r + 3]} - mm;
                  pa += d0 * d0; pb += d1 * d1; pa += d2 * d2; pb += d3 * d3; }
              s2 = (pa.x + pa.y) + (pb.x + pb.y); }
            { float x0, x1; half_swap(s2, x0, x1); s2 = x0 + x1; } const float rstd = rsqrtf(s2 * (1.0f / 64.0f) + 64e-5f);
            bf16_t* yp = Y + ((size_t)b * SEQ + c * 64 + 32 * tt + r32) * DM + 384 + h * 64;
#pragma unroll
            for (int it = 0; it < 2; ++it) {
                const LAS u32x2* g1 = (const LAS u32x2*)(B + RWU_G1 + ((it * 2 + tt) * 64 + lane) * 32); const LAS u32x2* vb = (const LAS u32x2*)(B + RWU_VB + ((it * 2 + tt) * 64 + lane) * 32);
#pragma unroll
                for (int g = 0; g < 4; ++g) { const u32x2 gw = g1[g], vw = vb[g];
                    const float y0 = (O[it][4 * g] - mean) * rstd * bflo(gw.x) + bflo(vw.x), y1 = (O[it][4 * g + 1] - mean) * rstd * bfhi(gw.x) + bfhi(vw.x);
                    const float y2 = (O[it][4 * g + 2] - mean) * rstd * bflo(gw.y) + bflo(vw.y), y3 = (O[it][4 * g + 3] - mean) * rstd * bfhi(gw.y) + bfhi(vw.y);
                    u32x2 x; x.x = pk2(y0, y1); x.y = pk2(y2, y3); *(u32x2*)(yp + 32 * it + 8 * g + 4 * hi) = x; }
            }
        }
    }
    __syncthreads();
}
#if defined(SELFCHECK)
__device__ __forceinline__ int t5_bucket_dev(int n) { if (n < 16) return n; int bk = 16 + (int)(logf((float)n / 16.0f) / logf(8.0f) * 16.0f); return bk > 31 ? 31 : bk; }

__device__ __forceinline__ void check_attention(const Frame& F) {
    const bf16_t* P = (const bf16_t*)(F.ws + WS_P); const bf16_t* MKV = (const bf16_t*)(F.ws + WS_MKV); const bf16_t* Y = (const bf16_t*)(F.ws + WS_Y);
    LAS float* sc = (LAS float*)F.lds + F.wave * 2048;
    const int lane = F.lane;
    for (int rep = 0; rep < 2; ++rep) {
        const int sidx = (rep * F.G + F.bid) * 8 + F.wave;
        const int b = sidx % 8, h = (sidx / 8) % 6, s = (sidx * 977 + 123) % 2048, qb = s >> 8;
        const size_t tok = (size_t)b * SEQ + s;
        {
            float qall[64];
#pragma unroll
            for (int d = 0; d < 64; ++d) qall[d] = bf2f(P[tok * INC + C_Q + h * 64 + d]);
            const float qv = bf2f(P[tok * INC + C_Q + h * 64 + lane]);
            float gate[8]; unsigned mask = 0;
#pragma unroll
            for (int n = 0; n < 8; ++n) { gate[n] = -INFINITY;
                if (n < qb) { float km = 0.f; for (int j = 0; j < 256; ++j) km += bf2f(P[((size_t)b * SEQ + n * 256 + j) * INC + C_K + h * 64 + lane]); gate[n] = wave_sum(qv * km * (1.0f / 256.0f)); } }
            if (qb <= 3) mask = (1u << qb) - 1u; else {
#pragma unroll
                for (int r = 0; r < 3; ++r) { float bv = -INFINITY; int bi = 0;
#pragma unroll
                    for (int n = 0; n < 8; ++n) { const bool take = !((mask >> n) & 1u) && gate[n] > bv; bv = take ? gate[n] : bv; bi = take ? n : bi; }
                    mask |= 1u << bi; } }
            float mx = -INFINITY;
            for (int j = lane; j <= s; j += 64) { const int nk = j >> 8; const bool ok = (nk == qb) || ((mask >> nk) & 1u);
                float dot = 0.f; const bf16_t* kp = P + ((size_t)b * SEQ + j) * INC + C_K + h * 64;
#pragma unroll
                for (int d = 0; d < 64; ++d) dot += qall[d] * bf2f(kp[d]);
                const float v = ok ? dot * 0.6931471805599453f + F.in[I_RELB][t5_bucket_dev(s - j) * 6 + h] : -INFINITY; sc[j] = v; mx = fmaxf(mx, v); }
#pragma unroll
            for (int o = 32; o >= 1; o >>= 1) mx = fmaxf(mx, __shfl_xor(mx, o));
            float sum = 0.f;
            for (int j = lane; j <= s; j += 64) { const float p = __expf(sc[j] - mx); sc[j] = p; sum += p; }
            sum = wave_sum(sum);
            float o = 0.f;
            for (int j = 0; j <= s; ++j) { const float p = sc[j]; if (p != 0.f) o += p * bf2f(P[((size_t)b * SEQ + j) * INC + C_V + h * 64 + lane]); }
            o /= sum;
            const float y = bf2f(Y[tok * DM + h * 64 + lane]);
            const float e2 = wave_sum((y - o) * (y - o)), r2 = wave_sum(o * o);
            if (lane == 0 && !(e2 <= 0.0009f * r2 + 1e-12f)) atomicAdd(F.ctl() + 48, 1u);
        }
        if (h < 4) {
            float qall[64];
#pragma unroll
            for (int d = 0; d < 64; ++d) qall[d] = bf2f(P[tok * INC + C_MQ + h * 64 + d]);
            float mx = -INFINITY;
            for (int j = lane; j < 256; j += 64) { float dot = 0.f; const bf16_t* kp = MKV + ((size_t)b * NMEM + j) * 512 + h * 64;
#pragma unroll
                for (int d = 0; d < 64; ++d) dot += qall[d] * bf2f(kp[d]);
                sc[j] = dot * 0.6931471805599453f; mx = fmaxf(mx, dot * 0.6931471805599453f); }
#pragma unroll
            for (int o = 32; o >= 1; o >>= 1) mx = fmaxf(mx, __shfl_xor(mx, o));
            float sum = 0.f;
            for (int j = lane; j < 256; j += 64) { const float p = __expf(sc[j] - mx); sc[j] = p; sum += p; }
            sum = wave_sum(sum);
            float o = 0.f;
            for (int j = 0; j < 256; ++j) o += sc[j] * bf2f(MKV[((size_t)b * NMEM + j) * 512 + 256 + h * 64 + lane]);
            o /= sum;
            const float y = bf2f(Y[tok * DM + 768 + h * 64 + lane]);
            const float e2 = wave_sum((y - o) * (y - o)), r2 = wave_sum(o * o);
            if (lane == 0 && !(e2 <= 0.0009f * r2 + 1e-12f)) atomicAdd(F.ctl() + 49, 1u);
        }
    }
}

__device__ __forceinline__ void check_rwkv(const Frame& F) {
    constexpr int NCK = 200;
    if (F.bid >= 48) return;
    const int b = F.bid / 6, h = F.bid % 6, tid = F.tid;
    const bf16_t* P = (const bf16_t*)(F.ws + WS_P); const bf16_t* Y = (const bf16_t*)(F.ws + WS_Y); const float* mu = F.in[I_MU];
    LAS float* L = (LAS float*)F.lds;
    LAS float* xs = L;
    LAS float* vr = L + 1408, *vk = vr + 64, *vv = vk + 64, *va = vv + 64, *vb = va + 64, *vw = vb + 64, *vg = vw + 64, *vo = vg + 64, *red = vo + 64;
    float S[8];
#pragma unroll
    for (int e = 0; e < 8; ++e) S[e] = 0.f;
    const int i = tid >> 3, jg = tid & 7;
    for (int t = 0; t < NCK; ++t) {
        const size_t tok = (size_t)b * SEQ + t;
        for (int c = tid; c < 1408; c += NTHREADS) { const float cur = bf2f(P[tok * INC + C_RW + c]); const float prev = t > 0 ? bf2f(P[(tok - 1) * INC + C_RW + c]) : 0.f; xs[c] = cur + (prev - cur) * mu[c]; }
        __syncthreads();
        if (tid < 64) { const int j = tid, cj = h * 64 + j;
            float lw = 0.f, la = 0.f, lg = 0.f;
            for (int k = 0; k < 64; ++k) { lw += tanhf(xs[RW_XW + k]) * F.in[I_WUP][k * 384 + cj]; la += xs[RW_XA + k] * F.in[I_AUP][k * 384 + cj]; }
            for (int k = 0; k < 128; ++k) lg += (1.0f / (1.0f + expf(-xs[RW_XG + k]))) * F.in[I_GUP][k * 384 + cj];
            const float z = -(F.in[I_W0][cj] + lw); const float sp = z > 20.f ? z : log1pf(expf(z)); const float w = -sp - 0.5f;
            vw[j] = expf(-expf(w));
            const float a = 1.0f / (1.0f + expf(-(F.in[I_A0][cj] + la)));
            const float k0 = xs[RW_K + cj];
            vr[j] = xs[RW_R + cj]; vv[j] = xs[RW_V + cj]; vg[j] = lg;
            const float kk = k0 * F.in[I_KK][cj];
            vk[j] = k0 * (1.0f + (a - 1.0f) * F.in[I_KA][cj]);
            va[j] = kk; vb[j] = a;
        }
        __syncthreads();
        float kn_ = 0.f, a_ = 0.f;
        if (tid < 64) { float ss = 0.f; for (int j = 0; j < 64; ++j) ss += va[j] * va[j]; const float inv = 1.0f / fmaxf(sqrtf(ss), 1e-12f); kn_ = va[tid] * inv; a_ = vb[tid]; }
        __syncthreads();
        if (tid < 64) { va[tid] = -kn_; vb[tid] = kn_ * a_; }
        __syncthreads();
        float sa = 0.f;
#pragma unroll
        for (int e = 0; e < 8; ++e) sa += S[e] * va[jg * 8 + e];
        sa += __shfl_xor(sa, 1); sa += __shfl_xor(sa, 2); sa += __shfl_xor(sa, 4);
        float o = 0.f;
#pragma unroll
        for (int e = 0; e < 8; ++e) { const int j = jg * 8 + e; S[e] = S[e] * vw[j] + sa * vb[j] + vv[i] * vk[j]; o += S[e] * vr[j]; }
        o += __shfl_xor(o, 1); o += __shfl_xor(o, 2); o += __shfl_xor(o, 4);
        if (jg == 0) vo[i] = o;
        __syncthreads();
        if (tid < 64) { float m = 0.f; for (int q = 0; q < 64; ++q) m += vo[q]; m *= (1.0f / 64.0f); float var = 0.f; for (int q = 0; q < 64; ++q) var += (vo[q] - m) * (vo[q] - m); var *= (1.0f / 64.0f);
            float bon = 0.f; for (int q = 0; q < 64; ++q) bon += vr[q] * vk[q] * F.in[I_RK][h * 64 + q];
            const int cj = h * 64 + tid;
            float y = (vo[tid] - m) * rsqrtf(var + 64e-5f) * F.in[I_GNG][cj] + F.in[I_GNB][cj]; y = (y + bon * vv[tid]) * vg[tid];
            const float yk = bf2f(Y[tok * DM + 384 + cj]);
            const float e2 = wave_sum((y - yk) * (y - yk)), r2 = wave_sum(y * y);
            if (tid == 0 && !(e2 <= 0.0009f * r2 + 1e-12f)) atomicAdd(F.ctl() + 50, 1u); }
        __syncthreads();
    }
}

__device__ __forceinline__ void check_moe(const Frame& F) {
    const int tok = (F.bid * 6151 + 77) % NTOK, tid = F.tid;
    const bf16_t* X1 = (const bf16_t*)(F.ws + WS_XB); LAS float* L = (LAS float*)F.lds; LAS float* xh = L, *hid = L + 1024, *lg = L + 2048, *yacc = L + 2112  ; LAS int* te = (LAS int*)(L + 3200); LAS float* tw = L + 3210;
    float ss = 0.f; for (int k = tid; k < 1024; k += NTHREADS) { const float v = bf2f(__builtin_bit_cast(unsigned short, X1[(size_t)tok * DM + k])); ss += v * v; }
    ss = wave_sum(ss); if (F.lane == 0) lg[40 + F.wave] = ss; __syncthreads();
    float tot = 0.f; for (int w = 0; w < 8; ++w) tot += lg[40 + w]; const float rs = rsqrtf(tot * (1.0f / DM) + 1e-5f);
    for (int k = tid; k < 1024; k += NTHREADS) { xh[k] = bf2f(__builtin_bit_cast(unsigned short, X1[(size_t)tok * DM + k])) * rs * F.in[I_GFFN][k]; yacc[k] = 0.f; }
    __syncthreads();
    if (tid < 32) { float a = F.in[I_BR][tid]; for (int k = 0; k < 1024; ++k) a += xh[k] * F.in[I_WR][k * 32 + tid]; lg[tid] = a; }
    __syncthreads();
    if (tid == 0) { float v[4]; for (int r = 0; r < 4; ++r) { float bv = -INFINITY; int bi = 0; for (int e = 0; e < 32; ++e) if (lg[e] > bv) { bv = lg[e]; bi = e; } v[r] = bv; te[r] = bi; lg[bi] = -INFINITY; }
        float den = 0.f; for (int r = 0; r < 4; ++r) den += expf(v[r] - v[0]); for (int r = 0; r < 4; ++r) tw[r] = expf(v[r] - v[0]) / den; }
    __syncthreads();
    for (int r = 0; r < 4; ++r) { const int e = te[r]; const float* W = F.in[I_WGU] + (size_t)e * 1024 * 2048; const float* Bg = F.in[I_BGU] + (size_t)e * 2048;
        for (int j = tid; j < 1024; j += NTHREADS) { float g = Bg[2 * j], u = Bg[2 * j + 1]; for (int k = 0; k < 1024; ++k) { const f32x2 w2 = *(const f32x2*)(W + (size_t)k * 2048 + 2 * j); g += xh[k] * w2[0]; u += xh[k] * w2[1]; }
            g = fminf(g, 7.0f); u = fminf(fmaxf(u, -7.0f), 7.0f); hid[j] = (u + 1.0f) * g / (1.0f + expf(-1.702f * g)); }
        __syncthreads();
        const float* W2 = F.in[I_WDN] + (size_t)e * 1024 * 1024;
        for (int n = tid; n < 1024; n += NTHREADS) { float a = F.in[I_BDN][(size_t)e * 1024 + n]; for (int j = 0; j < 1024; ++j) a += hid[j] * W2[(size_t)j * 1024 + n]; yacc[n] += a * tw[r]; }
        __syncthreads(); }
    const bf16_t* YE = (const bf16_t*)(F.ws + WS_YE);
    float e2 = 0.f, r2 = 0.f;
    for (int n = tid; n < 1024; n += NTHREADS) { float y = 0.f; for (int k = 0; k < 4; ++k) { if (YE_ESZ == 2) y += bf2f(YE[(size_t)(tok * 4 + k) * DM + n]); else { const unsigned char q8 = ((const unsigned char*)YE)[(size_t)(tok * 4 + k) * DM + n]; y += __builtin_amdgcn_cvt_f32_fp8((unsigned)q8, 0) * (1.0f / YE_SCALE); } } e2 += (y - yacc[n]) * (y - yacc[n]); r2 += yacc[n] * yacc[n]; }
    e2 = wave_sum(e2); r2 = wave_sum(r2); if (F.lane == 0) { lg[48 + F.wave] = e2; lg[56 + F.wave] = r2; } __syncthreads();
    if (tid == 0) { float a = 0.f, c = 0.f; for (int w = 0; w < 8; ++w) { a += lg[48 + w]; c += lg[56 + w]; } if (!(a <= (MOE_FP8 ? 0.0225f : 0.0009f) * c + 1e-12f)) atomicAdd(F.ctl() + 51, 1u); }
    __syncthreads();
}
#endif
__global__ void __launch_bounds__(NTHREADS, 2) hymba_fwd(Params prm) {
    extern __shared__ __attribute__((aligned(16))) unsigned char lds_raw[];
    cg::grid_group grid = cg::this_grid();
    Frame F; F.lds = (LAS unsigned char*)lds_raw; F.tid = threadIdx.x; F.lane = F.tid & 63; F.wave = __builtin_amdgcn_readfirstlane(F.tid >> 6); F.G = gridDim.x; F.bid = blockIdx.x;
    F.in = prm.in; F.out = prm.out; F.ws = prm.ws;
    unsigned char* ws = prm.ws;
    volatile LAS unsigned* bar_st = (volatile LAS unsigned*)(F.lds + LDS_BYTES - 16);
    if (threadIdx.x == 0) { bar_st[0] = 0u; bar_st[1] = 0u; }
    unsigned* bar_words = (unsigned*)(ws + WS_CTL + 65536);
    if (F.bid == 0) for (int i = threadIdx.x; i < XCD_BAR_WORDS; i += NTHREADS) bar_words[i] = 0u;
#if defined(PROBE_I)
#define STAMP(k) do { if (F.bid == 0 && threadIdx.x == 0) ((unsigned long long*)(ws + WS_CTL + 4096))[k] = __builtin_amdgcn_s_memrealtime(); } while (0)
#else
#define STAMP(k) do {} while (0)
#endif
#ifndef NGEMM
#define NGEMM 180
#endif
#ifndef CONV_X
#define CONV_X 6912
#endif
#ifndef CONV_D
#define CONV_D 20
#endif
#ifndef DOUBLE_PHASE
#define DOUBLE_PHASE -1
#endif
#define REP(k) for (int rep_ = 0; rep_ < ((DOUBLE_PHASE == (k)) ? 2 : 1); ++rep_)
#define RELAUNDER() do { int t_ = threadIdx.x; asm volatile("" : "+v"(t_)); F.tid = t_; F.lane = t_ & 63; } while (0)
#if defined(TIMING_SCAFFOLD)
#define EXIT_AFTER(k) do { if (prm.phase_hi <= (k)) return; } while (0)
#else
#define EXIT_AFTER(k) do {} while (0)
#endif
#ifndef NPASS
#define NPASS 1
#endif
    XcdBarrier xbar; xbar.bar = bar_words; xbar.x = 0; xbar.st = bar_st;
#pragma unroll 1
    for (int pass_ = 0; pass_ < NPASS; ++pass_) {
#if defined(TIMING_SCAFFOLD)
    if (prm.phase_hi < 0) {
        const int m = -prm.phase_hi;
        if (m <= 2) exp_stream_read(F, m);
        else if (m == 3) { if (F.bid < NGEMM) { pg8::StaticOrder S; S.init(NTOK, INC, NGEMM, F.bid); EpiRowScaleBf16 E{(bf16_t*)(ws + WS_P), INC, (const float*)(ws + WS_RS1)};
              pg8::gemm_phase<false, 2>(F.lds, (const bf16_t*)(ws + WS_XB), (const bf16_t*)(ws + WS_WIN), DM, S, E); } }
        else if (m == 4) { if (F.bid >= NGEMM) moe_weight_conversion(F, F.bid - NGEMM, F.G - NGEMM, MOE_TT, MOE_TT); }
        else if (m == 5) { moe_weight_conversion(F, F.bid, F.G, MOE_TT, MOE_TT); }
        else if (m == 7 || m == 8 || m == 9) { if (F.bid == 0 && F.tid < 64) F.ctl()[F.tid] = 0u; grid.sync();
            if (m == 7) attention_phase(F, 32); else if (m == 8) { if (F.bid < NB * 6) rwkv_scan(F, F.bid / 6, F.bid % 6); } else rwkv_chunk_phase(F); }
        else if (m == 6) { pg8::StaticOrder S; S.init(NTOK, INC, F.G, F.bid); EpiRowScaleBf16 E{(bf16_t*)(ws + WS_P), INC, (const float*)(ws + WS_RS1)};
              pg8::gemm_phase<false, 2>(F.lds, (const bf16_t*)(ws + WS_XB), (const bf16_t*)(ws + WS_WIN), DM, S, E); }
        return; }
#endif
    EXIT_AFTER(0);
    if (pass_ > 0) xcd_barrier(xbar);
    STAMP(0);
    REP(0) p0_prologue(F);
    grid.sync(); RELAUNDER(); STAMP(1); EXIT_AFTER(1);
    if (pass_ == 0) xbar = xcd_barrier_post(bar_words, bar_st);
    REP(1) {
    if (F.bid < NGEMM) {
        Frame F2 = F; F2.G = NGEMM;
        kmean_task(F2);
        { pg8::StaticOrder S; S.init(NTOK, INC, NGEMM, F.bid); EpiRowScaleBf16 E{(bf16_t*)(ws + WS_P), INC, (const float*)(ws + WS_RS1)};
          pg8::gemm_phase<false, 2>(F.lds, (const bf16_t*)(ws + WS_XB), (const bf16_t*)(ws + WS_WIN), DM, S, E); }
        { pg8::StaticOrder S; S.init(NB * NMEM, 512, NGEMM, (F.bid + 16) % NGEMM); EpiRowScaleBf16 E{(bf16_t*)(ws + WS_MKV), 512, (const float*)(ws + WS_RS1 + 65536)};
          pg8::gemm_phase<false, 2>(F.lds, (const bf16_t*)(ws + WS_MEMB), (const bf16_t*)(ws + WS_WMKV), DM, S, E); }
    }
#if DOUBLE_PHASE == 1
    moe_weight_conversion(F, F.bid >= NGEMM ? F.bid - NGEMM : -1, F.G - NGEMM, CONV_X, MOE_T1);
    }
    xcd_barrier(xbar); RELAUNDER(); STAMP(2); EXIT_AFTER(2);
#else
    }
    { const unsigned tok_ = xcd_barrier_arrive(xbar);
      moe_weight_conversion(F, F.bid >= NGEMM ? F.bid - NGEMM : -1, F.G - NGEMM, CONV_X, MOE_T1);
      xcd_barrier_finish(xbar, tok_); }
    RELAUNDER(); STAMP(2); EXIT_AFTER(2);
#endif
#ifndef CHUNK_CUT
#define CHUNK_CUT 7
#endif
    rwkv_chunk_phase(F);
    if (DOUBLE_PHASE == 2) { __syncthreads(); rwkv_chunk_phase<CHUNK_CUT>(F); }
#if DOUBLE_PHASE == 3
    xcd_barrier(xbar); RELAUNDER(); STAMP(3); EXIT_AFTER(3);
    REP(3) { if (F.bid < NB * 6) rwkv_scan(F, F.bid / 6, F.bid % 6);
    RELAUNDER();
    attention_phase(F, 32 + rep_); }
#else
    { const unsigned tok_ = xcd_barrier_arrive(xbar);
      if (F.bid < NB * 6) { xcd_barrier_finish(xbar, tok_); RELAUNDER(); rwkv_scan(F, F.bid / 6, F.bid % 6); }
      RELAUNDER();
      attention_phase(F, 32);
      if (F.bid >= NB * 6) xcd_barrier_finish(xbar, tok_); }
#endif
    if (DOUBLE_PHASE == 31) { xcd_barrier(xbar); RELAUNDER(); if (F.bid < NB * 6) rwkv_scan(F, F.bid / 6, F.bid % 6); }
#ifndef ATT_VAR
#define ATT_VAR 1
#endif
    if (DOUBLE_PHASE == 32) { xcd_barrier(xbar); RELAUNDER(); attention_phase<ATT_VAR>(F, 33); }
    xcd_barrier(xbar); RELAUNDER(); STAMP(4); EXIT_AFTER(4);
#if defined(SELFCHECK)
    check_attention(F); __syncthreads(); check_rwkv(F); __syncthreads();
#endif
    REP(4) { pg8::StaticOrder S; S.init(NTOK, DM, F.G, F.bid); EpiResidual E{(bf16_t*)(ws + WS_XB), ws + WS_X1B};
      pg8::gemm_phase<false, 2>(F.lds, (const bf16_t*)(ws + WS_Y), (const bf16_t*)(ws + WS_WOUT), DM, S, E); }
    __syncthreads(); router_stage_w(F);
    xcd_barrier(xbar); RELAUNDER(); STAMP(5); EXIT_AFTER(5);
    if (DOUBLE_PHASE == 7) { router_phase(F, true, false); __syncthreads(); }
    router_phase(F, false, false);
    xcd_barrier(xbar); RELAUNDER(); STAMP(6); EXIT_AFTER(6);
    const UTab TG = build_unit_table<MAXU_GU>(F, 8, 0), TD = build_unit_table<MAXU_DN>(F, 4, UTAB_DN_OFF);
    REP(5) { pg8::TableOrder S{TG.meta, TG.rows, TG.nunits, 0};
      EpiSwiglu E{TG.meta, TG.rows, (const float*)(ws + WS_RS1 + 131072), F.in[I_BGU], ws + WS_HMID};
      pg8::gemm_phase<true, MOE_ESZ>(F.lds, ws + WS_X1B, ws + WS_WGU, DM, S, E); }
    { const int U = TG.pre[NEXP] * 8, r = U % F.G, light = F.G - r;
      int d = CONV_D; if (d * light > MOE_T2) d = MOE_T2 / light;
      const int a = (MOE_T2 - d * light) / F.G, rem = MOE_T2 - (a * F.G + d * light);
      const int heavy = F.bid < r ? 1 : 0;
      const int base = heavy ? F.bid * a : r * a + (F.bid - r) * (a + d);
      const int lo = base + (F.bid < rem ? F.bid : rem), cnt = (heavy ? a : a + d) + (F.bid < rem ? 1 : 0);
      RELAUNDER();
      moe_convert_run(F, MOE_T1 + lo, cnt, false); }
    xcd_barrier(xbar); RELAUNDER(); STAMP(7); EXIT_AFTER(7);
    REP(6) { pg8::TableOrder S{TD.meta, TD.rows, TD.nunits, 1};
      EpiDown E{TD.meta, TD.rows, (const float*)(ws + WS_TOPW), F.in[I_BDN], ws + WS_YE};
      pg8::gemm_phase<true, MOE_ESZ>(F.lds, ws + WS_HMID, ws + WS_WDN, DM, S, E); }
    xcd_barrier(xbar); RELAUNDER(); STAMP(8); EXIT_AFTER(8);
#if defined(SELFCHECK)
    check_moe(F); grid.sync();
#endif
    if (DOUBLE_PHASE == 8) { final_phase(F, true); grid.sync(); }
    if (DOUBLE_PHASE == 9) { for (int q = 0; q < 8; ++q) grid.sync(); }
    final_phase(F);
    }
#if defined(PROBE_I)
    STAMP(9);
    xcd_barrier(xbar);
    { const unsigned long long* ts = (const unsigned long long*)(ws + WS_CTL + 4096);
      const int pa[11] = {0, 1, 2, 3, 4, 5, 6, 7, 8, 3, 0}, pb[11] = {1, 2, 3, 4, 5, 6, 7, 8, 9, 10, 9};
      const float di = (float)(ts[pb[PROBE_I]] - ts[pa[PROBE_I]]) * 0.01f, dj = (float)(ts[pb[PROBE_J]] - ts[pa[PROBE_J]]) * 0.01f;
      const float ni = floorf((di + PROBE_OFF) * (1.0f / PROBE_BIN)), nj = floorf((dj + PROBE_OFF) * (1.0f / PROBE_BIN));
      const float sc = 1.0f + 0.1f * ni;
      for (size_t i = (size_t)F.bid * NTHREADS + F.tid; i < (size_t)NTOK * DM; i += (size_t)F.G * NTHREADS) F.out[i] = F.out[i] * sc + (i == 0 ? 50.0f * nj : 0.f); }
#endif
    if (xb_ld(&bar_words[XB_TMO]) != 0u) { for (size_t i = (size_t)F.bid * NTHREADS + F.tid; i < (size_t)NTOK * DM; i += (size_t)F.G * NTHREADS) F.out[i] = __builtin_nanf(""); }
#if defined(SELFCHECK)
    { const unsigned* c = F.ctl(); const unsigned mask = (c[48] > 40u ? 1u : 0u) | (c[49] > 2u ? 2u : 0u) | (c[50] > 2u ? 4u : 0u) | (c[51] > 0u ? 8u : 0u);
      if (mask) { grid.sync(); const float sc = 1.0f + 0.1f * (float)mask; for (size_t i = (size_t)F.bid * NTHREADS + F.tid; i < (size_t)NTOK * DM; i += (size_t)F.G * NTHREADS) F.out[i] *= sc; } }
#endif
}

extern "C" void kernel_launch(void* const* d_in, const int* in_sizes, int n_in, void* d_out, int out_size, void* d_ws, size_t ws_size, hipStream_t stream) {
    static int grid = 0;
    if (grid == 0) {
        if (n_in != 27 || out_size != NTOK * DM || ws_size < WS_END) { fprintf(stderr, "kernel_launch: unexpected problem (n_in %d, out %d, ws %zu)\n", n_in, out_size, ws_size); grid = -1; return; }
        int dev = 0, cus = 0, per_cu = 0;
        hipGetDevice(&dev); hipDeviceGetAttribute(&cus, hipDeviceAttributeMultiprocessorCount, dev);
        if (hipFuncSetAttribute((const void*)hymba_fwd, hipFuncAttributeMaxDynamicSharedMemorySize, LDS_BYTES) != hipSuccess) { fprintf(stderr, "kernel_launch: hipFuncSetAttribute failed\n"); }
        if (hipOccupancyMaxActiveBlocksPerMultiprocessor(&per_cu, (const void*)hymba_fwd, NTHREADS, LDS_BYTES) != hipSuccess || per_cu < 1) { fprintf(stderr, "kernel_launch: occupancy query says %d\n", per_cu); per_cu = 1; }
        (void)hipGetLastError();
        grid = cus;
        fprintf(stderr, "kernel_launch: grid %d (per_cu %d)\n", grid, per_cu);
    }
    if (grid < 0) return;
    Params p{};
    for (int i = 0; i < 27; ++i) p.in[i] = (const float*)d_in[i];
    p.out = (float*)d_out; p.ws = (unsigned char*)d_ws; p.phase_hi = 99;
#if defined(PARTIAL_K)
    { Params q = p; q.phase_hi = PARTIAL_K; void* qa[] = {&q}; (void)hipLaunchCooperativeKernel((const void*)hymba_fwd, dim3(grid), dim3(NTHREADS), qa, LDS_BYTES, stream); }
#endif
    void* args[] = {&p};
    hipError_t e = hipLaunchCooperativeKernel((const void*)hymba_fwd, dim3(grid), dim3(NTHREADS), args, LDS_BYTES, stream);
    if (e != hipSuccess) fprintf(stderr, "kernel_launch: cooperative launch failed: %s (grid %d)\n", hipGetErrorString(e), grid);
#if defined(TWICE)
    e = hipLaunchCooperativeKernel((const void*)hymba_fwd, dim3(grid), dim3(NTHREADS), args, LDS_BYTES, stream);
#endif
}
```
